# Optimizing an MI355X kernel written in HIP

```python
import jax, jax.numpy as jnp
from jax import lax
import numpy as np

D_MODEL = 2048
BATCH = 1
SEQ = 8192
DEPTH = 2

GRID_W = 64
CTX_LEN = 256
HEAD_DIM = 128
N_Q_HEADS = D_MODEL // HEAD_DIM
N_KV_HEADS = N_Q_HEADS // 4
GQA_GROUP = N_Q_HEADS // N_KV_HEADS
WINDOW = 128
BLOCK = 128
ROPE_AXIS_DIM = HEAD_DIM // 2
ROPE_PAIRS = ROPE_AXIS_DIM // 2
ROPE_BASE = 10000.0
POOL_WINDOWS = (2, 4, 8, 16)
POOL_WIDTH = D_MODEL // 2
POOL_GROUP = POOL_WIDTH // len(POOL_WINDOWS)
CONV_WIDTH = D_MODEL // 2
N_BRANCHES = 3
D_FF = 256 * ((8 * D_MODEL // 3 + 255) // 256)
N_MODS = 9
EPS = 1e-6
NEG_INF = -1e30

ATTN_WIDTH = N_Q_HEADS * HEAD_DIM
KV_WIDTH = N_KV_HEADS * HEAD_DIM
Q_OFF = 0
K_OFF = Q_OFF + ATTN_WIDTH
V_OFF = K_OFF + KV_WIDTH
POOL_OFF = V_OFF + KV_WIDTH
CB_OFF = POOL_OFF + POOL_WIDTH
CC_OFF = CB_OFF + CONV_WIDTH
CX_OFF = CC_OFF + CONV_WIDTH
GATE_OFF = CX_OFF + CONV_WIDTH
IN_COLS = GATE_OFF + N_BRANCHES * D_MODEL

kernel_name = "hybrid_pool_conv_swa_dit_block"


def rms_norm(x, g):
    xf = x.astype(jnp.float32)
    y = xf * lax.rsqrt(jnp.mean(xf * xf, axis=-1, keepdims=True) + EPS)
    return (y * g.astype(jnp.float32)).astype(x.dtype)


def modulate(xn, shift, scale):
    return xn * (1 + scale) + shift


def swiglu(x, wi, wo):
    g, u = jnp.split(x @ wi, 2, axis=-1)
    return (jax.nn.silu(g) * u) @ wo


def axial_rope_tables(L):
    rows = L // GRID_W
    r = jnp.repeat(jnp.arange(rows, dtype=jnp.float32), GRID_W)
    col = jnp.tile(jnp.arange(GRID_W, dtype=jnp.float32), rows)
    inv = ROPE_BASE ** (-jnp.arange(ROPE_PAIRS, dtype=jnp.float32) / ROPE_PAIRS)
    ang = jnp.stack([r[:, None] * inv, col[:, None] * inv], axis=1)
    return jnp.cos(ang), jnp.sin(ang)


def apply_axial_rope(t, cos, sin):
    B, L, H, _ = t.shape
    tt = t.reshape(B, L, H, 2, ROPE_AXIS_DIM)
    t1, t2 = tt[..., :ROPE_PAIRS], tt[..., ROPE_PAIRS:]
    c = cos[None, :, None].astype(t.dtype)
    s = sin[None, :, None].astype(t.dtype)
    out = jnp.concatenate([t1 * c - t2 * s, t2 * c + t1 * s], axis=-1)
    return out.reshape(B, L, H, HEAD_DIM)


def windowed_attention(q, k, v, kc, vc, sink):
    B, L = q.shape[0], q.shape[1]
    nb = L // BLOCK
    qb = q.reshape(B, nb, BLOCK, N_KV_HEADS, GQA_GROUP, HEAD_DIM)

    def band(t):
        tb = t.reshape(B, nb, BLOCK, N_KV_HEADS, HEAD_DIM)
        tp = jnp.pad(tb, ((0, 0), (1, 1), (0, 0), (0, 0), (0, 0)))
        return jnp.concatenate([tp[:, :-2], tp[:, 1:-1], tp[:, 2:]], axis=2)

    kb, vb = band(k), band(v)
    scale = HEAD_DIM ** -0.5
    s_loc = jnp.einsum('bnqhgd,bnshd->bnhgqs', qb, kb).astype(jnp.float32) * scale
    s_ctx = jnp.einsum('bnqhgd,bchd->bnhgqc', qb, kc).astype(jnp.float32) * scale
    blk = jnp.arange(nb)[:, None, None]
    qpos = blk * BLOCK + jnp.arange(BLOCK)[None, :, None]
    kpos = (blk - 1) * BLOCK + jnp.arange(3 * BLOCK)[None, None, :]
    valid = (jnp.abs(kpos - qpos) <= WINDOW) & (kpos >= 0) & (kpos < L)
    s_loc = jnp.where(valid[None, :, None, None], s_loc, NEG_INF)
    s_sink = jnp.broadcast_to(
        sink.astype(jnp.float32).reshape(1, 1, N_KV_HEADS, GQA_GROUP, 1, 1), s_loc.shape[:-1] + (1,))
    p = jax.nn.softmax(jnp.concatenate([s_loc, s_ctx, s_sink], axis=-1), axis=-1)
    n_loc = 3 * BLOCK
    p_loc = p[..., :n_loc].astype(v.dtype)
    p_ctx = p[..., n_loc:n_loc + kc.shape[1]].astype(v.dtype)
    o = (jnp.einsum('bnhgqs,bnshd->bnqhgd', p_loc, vb)
         + jnp.einsum('bnhgqc,bchd->bnqhgd', p_ctx, vc))
    return o.reshape(B, L, ATTN_WIDTH)


def context_attention(q, k, v, sink):
    B, Lc = q.shape[0], q.shape[1]
    qg = q.reshape(B, Lc, N_KV_HEADS, GQA_GROUP, HEAD_DIM)
    s = jnp.einsum('bqhgd,bkhd->bhgqk', qg, k).astype(jnp.float32) * (HEAD_DIM ** -0.5)
    s_sink = jnp.broadcast_to(
        sink.astype(jnp.float32).reshape(1, N_KV_HEADS, GQA_GROUP, 1, 1), s.shape[:-1] + (1,))
    p = jax.nn.softmax(jnp.concatenate([s, s_sink], axis=-1), axis=-1)[..., :-1].astype(v.dtype)
    o = jnp.einsum('bhgqk,bkhd->bqhgd', p, v)
    return o.reshape(B, Lc, ATTN_WIDTH)


def multiscale_pool(u, pool_w, pool_scale):
    B, L, _ = u.shape
    uf = u.astype(jnp.float32)
    cs = jnp.concatenate([jnp.zeros((B, 1, POOL_WIDTH), jnp.float32), jnp.cumsum(uf, axis=1)], axis=1)
    t = jnp.arange(L)
    means = []
    for gi, w in enumerate(POOL_WINDOWS):
        lo = jnp.clip(t - w // 2, 0, L - 1)
        hi = jnp.clip(t + (w - w // 2) - 1, 0, L - 1)
        seg = cs[:, :, gi * POOL_GROUP:(gi + 1) * POOL_GROUP]
        cnt = (hi - lo + 1).astype(jnp.float32)[None, :, None]
        means.append((seg[:, hi + 1] - seg[:, lo]) / cnt)
    y = (jnp.concatenate(means, axis=-1) - uf).astype(u.dtype)
    y = jnp.einsum('blgc,gcd->blgd', y.reshape(B, L, len(POOL_WINDOWS), POOL_GROUP), pool_w)
    return y.reshape(B, L, POOL_WIDTH) * pool_scale


def short_conv(v, w):
    vp = jnp.pad(v, ((0, 0), (1, 1), (0, 0)))
    return vp[:, :-2] * w[0] + vp[:, 1:-1] * w[1] + vp[:, 2:] * w[2]


def parallel_merge(p, attn_o, pool_w, pool_scale, conv_w, w_attn_out, w_pool_out, w_conv_out, w_o):
    y_attn = attn_o @ w_attn_out
    y_pool = multiscale_pool(p[..., POOL_OFF:CB_OFF], pool_w, pool_scale) @ w_pool_out
    b_gate = p[..., CB_OFF:CC_OFF]
    c_gate = p[..., CC_OFF:CX_OFF]
    xv = p[..., CX_OFF:GATE_OFF]
    y_conv = (b_gate * short_conv(c_gate * xv, conv_w)) @ w_conv_out
    g = jax.nn.sigmoid(p[..., GATE_OFF:IN_COLS].astype(jnp.float32)).astype(p.dtype)
    g = g.reshape(p.shape[:-1] + (N_BRANCHES, D_MODEL))
    merged = g[..., 0, :] * y_attn + g[..., 1, :] * y_pool + g[..., 2, :] * y_conv
    return merged @ w_o


def setup_inputs(seed: int = 0) -> dict:
    key = jax.random.key(seed)
    ks = jax.random.split(key, 24)

    def dense(k, shape, fan_in, gain=1.0):
        return jax.random.normal(k, shape, jnp.float32) * (gain * fan_in ** -0.5)

    def near_one(k, shape, s):
        return 1.0 + s * jax.random.normal(k, shape, jnp.float32)

    D, F = D_MODEL, D_FF
    return {
        "x": jax.random.normal(ks[0], (BATCH, SEQ, D), jnp.float32),
        "c": jax.random.normal(ks[1], (BATCH, D), jnp.float32),
        "ctx": jax.random.normal(ks[2], (BATCH, CTX_LEN, D), jnp.float32),
        "c_ctx": jax.random.normal(ks[3], (D,), jnp.float32),
        "w_ada": dense(ks[4], (DEPTH, D, N_MODS * D), D, 0.5),
        "b_ada": 0.01 * jax.random.normal(ks[5], (DEPTH, N_MODS * D), jnp.float32),
        "norm_g": near_one(ks[6], (DEPTH, 3, D), 0.05),
        "ffn1_wi": dense(ks[7], (DEPTH, D, 2 * F), D),
        "ffn1_wo": dense(ks[8], (DEPTH, F, D), F),
        "w_in": dense(ks[9], (DEPTH, D, IN_COLS), D),
        "attn_sink": 0.5 * jax.random.normal(ks[10], (DEPTH, N_Q_HEADS), jnp.float32),
        "pool_w": dense(ks[11], (DEPTH, len(POOL_WINDOWS), POOL_GROUP, POOL_GROUP), POOL_GROUP),
        "pool_scale": near_one(ks[12], (DEPTH, POOL_WIDTH), 0.1),
        "conv_w": dense(ks[13], (DEPTH, 3, CONV_WIDTH), 3),
        "w_attn_out": dense(ks[14], (DEPTH, ATTN_WIDTH, D), ATTN_WIDTH),
        "w_pool_out": dense(ks[15], (DEPTH, POOL_WIDTH, D), POOL_WIDTH),
        "w_conv_out": dense(ks[16], (DEPTH, CONV_WIDTH, D), CONV_WIDTH),
        "w_o": dense(ks[17], (DEPTH, D, D), D),
        "ffn2_wi": dense(ks[18], (DEPTH, D, 2 * F), D),
        "ffn2_wo": dense(ks[19], (DEPTH, F, D), F),
        "final_g": near_one(ks[20], (D,), 0.05),
    }


def reference(x, c, ctx, c_ctx, w_ada, b_ada, norm_g, ffn1_wi, ffn1_wo, w_in, attn_sink, pool_w,
              pool_scale, conv_w, w_attn_out, w_pool_out, w_conv_out, w_o, ffn2_wi, ffn2_wo, final_g):
    B, L, D = x.shape
    Lc = ctx.shape[1]
    cos, sin = axial_rope_tables(L)
    h, hc = x, ctx
    for l in range(DEPTH):
        last = l == DEPTH - 1
        m = (jax.nn.silu(c) @ w_ada[l] + b_ada[l]).reshape(B, N_MODS, 1, D)
        mc = (jax.nn.silu(c_ctx) @ w_ada[l] + b_ada[l]).reshape(N_MODS, 1, 1, D)

        h = h + 0.5 * m[:, 2] * swiglu(
            modulate(rms_norm(h, norm_g[l, 0]), m[:, 0], m[:, 1]), ffn1_wi[l], ffn1_wo[l])
        hc = hc + 0.5 * mc[2] * swiglu(
            modulate(rms_norm(hc, norm_g[l, 0]), mc[0], mc[1]), ffn1_wi[l], ffn1_wo[l])

        xn = modulate(rms_norm(h, norm_g[l, 1]), m[:, 3], m[:, 4])
        xc = modulate(rms_norm(hc, norm_g[l, 1]), mc[3], mc[4])
        if last:
            kv_c = xc @ w_in[l][:, K_OFF:POOL_OFF]
        else:
            pc = xc @ w_in[l]
            kv_c = pc[..., K_OFF:POOL_OFF]
        kc = kv_c[..., :KV_WIDTH].reshape(B, Lc, N_KV_HEADS, HEAD_DIM)
        vc = kv_c[..., KV_WIDTH:].reshape(B, Lc, N_KV_HEADS, HEAD_DIM)

        p = xn @ w_in[l]
        q = apply_axial_rope(p[..., Q_OFF:K_OFF].reshape(B, L, N_Q_HEADS, HEAD_DIM), cos, sin)
        k = apply_axial_rope(p[..., K_OFF:V_OFF].reshape(B, L, N_KV_HEADS, HEAD_DIM), cos, sin)
        v = p[..., V_OFF:POOL_OFF].reshape(B, L, N_KV_HEADS, HEAD_DIM)
        attn = windowed_attention(q, k, v, kc, vc, attn_sink[l])
        h = h + m[:, 5] * parallel_merge(p, attn, pool_w[l], pool_scale[l], conv_w[l],
                                         w_attn_out[l], w_pool_out[l], w_conv_out[l], w_o[l])
        if not last:
            qc = pc[..., Q_OFF:K_OFF].reshape(B, Lc, N_Q_HEADS, HEAD_DIM)
            attn_c = context_attention(qc, kc, vc, attn_sink[l])
            hc = hc + mc[5] * parallel_merge(pc, attn_c, pool_w[l], pool_scale[l], conv_w[l],
                                             w_attn_out[l], w_pool_out[l], w_conv_out[l], w_o[l])

        h = h + 0.5 * m[:, 8] * swiglu(
            modulate(rms_norm(h, norm_g[l, 2]), m[:, 6], m[:, 7]), ffn2_wi[l], ffn2_wo[l])
        if not last:
            hc = hc + 0.5 * mc[8] * swiglu(
                modulate(rms_norm(hc, norm_g[l, 2]), mc[6], mc[7]), ffn2_wi[l], ffn2_wo[l])
    return rms_norm(h, final_g)
```

```cpp
#include <hip/hip_runtime.h>
#include <cstdio>
#include <cstdint>
namespace pg8 {
#define PG8_LAS __attribute__((address_space(3)))
typedef unsigned short bf16_t;
typedef short bf16x8 __attribute__((ext_vector_type(8)));
typedef float f32x4 __attribute__((ext_vector_type(4)));
typedef unsigned u32x4 __attribute__((ext_vector_type(4)));
constexpr int BM = 256, BK = 64, HALF = 128, HTB = HALF * BK * 2  , STAGE_BYTES = 8 * HTB, NXCD = 8, WGM = 8;

__host__ __device__ __forceinline__ int lds_byte(int r, int c) { const int st = (r >> 4) * 2 + (c >> 5), rr = r & 15, cc = c & 31, ob = rr * 64 + cc * 2; return st * 1024 + (ob ^ (((ob >> 9) & 1) << 5)); }
__host__ __device__ __forceinline__ void stage_rc(int b, int& R, int& C) { const int st = b / 1024, sb = b % 1024, swz = sb ^ (((sb >> 9) & 1) << 5); R = (st >> 1) * 16 + swz / 64; C = (st & 1) * 32 + (swz % 64) / 2; }
__host__ __device__ __forceinline__ int perm32(int rho) { const int n = rho >> 4, i = rho & 15; return 8 * (i >> 2) + 4 * n + (i & 3); }

struct Unit { int pm, pn, seg; };
struct Gemm { const bf16_t* A; const bf16_t* Bt; int K; };

struct StaticOrder {
    int nM, nN, nwg, G, c, ntk;
    __host__ __device__ void init(int M, int N, int K, int G_, int c_) { nM = M / BM; nN = N / BM; nwg = nM * nN; G = G_; c = c_; ntk = K / BK; }
    __device__ __forceinline__ int koff(const Unit&) const { return 0; }
    __device__ __forceinline__ int nt(const Unit&) const { return ntk; }
    __host__ __device__ bool next(int i, Unit& u) const {
        const long L = (long)i * G + c; if (L >= nwg) return false;
        int wgid = (int)L; { const int q = nwg / NXCD, r = nwg % NXCD, xcd = wgid % NXCD, off = wgid / NXCD; wgid = (xcd < r ? xcd * (q + 1) : r * (q + 1) + (xcd - r) * q) + off; }
        const int nig = WGM * nN, gid = wgid / nig, fm = gid * WGM, gsz = (nM - fm) < WGM ? (nM - fm) : WGM;
        u.pm = fm + ((wgid % nig) % gsz); u.pn = (wgid % nig) / gsz; u.seg = 0; return true;
    }
    __device__ __forceinline__ void a_ready(const Unit&) const {}
    __device__ __forceinline__ void done(const Unit&) const {}
};


__device__ __forceinline__ unsigned cvt_pk_bf16(float lo, float hi) { unsigned r; asm volatile("v_cvt_pk_bf16_f32 %0, %1, %2" : "=v"(r) : "v"(lo), "v"(hi)); return r; }

struct EpiF32 {
    static constexpr bool PERM = false, AFTER_DRAIN = false;
    float* C; int ldc;
    __device__ __forceinline__ void operator()(const f32x4 (&acc)[2][2][4][2], const Unit& u, int wr, int wc, int fr, int fq) const {
        const int row0 = u.pm * BM + wr * 64 + fr, col0 = u.pn * BM + wc * 32 + 4 * fq;
#pragma unroll
        for (int ai = 0; ai < 2; ++ai)
#pragma unroll
            for (int m = 0; m < 4; ++m) { float* rowp = C + (size_t)(row0 + ai * HALF + m * 16) * ldc + col0;
#pragma unroll
                for (int bj = 0; bj < 2; ++bj)
#pragma unroll
                    for (int n = 0; n < 2; ++n) *(f32x4*)(rowp + bj * HALF + n * 16) = acc[ai][bj][m][n]; }
    }
};
struct EpiBf16 {
    static constexpr bool PERM = true, AFTER_DRAIN = false;
    bf16_t* O; int ldc; size_t seg_stride;
    __device__ __forceinline__ void operator()(const f32x4 (&acc)[2][2][4][2], const Unit& u, int wr, int wc, int fr, int fq) const {
        const int row0 = u.pm * BM + wr * 64 + fr, col0 = u.pn * BM + wc * 32 + 8 * fq; bf16_t* base = O + (size_t)u.seg * seg_stride;
#pragma unroll
        for (int ai = 0; ai < 2; ++ai)
#pragma unroll
            for (int m = 0; m < 4; ++m) { bf16_t* rowp = base + (size_t)(row0 + ai * HALF + m * 16) * ldc + col0;
#pragma unroll
                for (int bj = 0; bj < 2; ++bj) { const f32x4 v0 = acc[ai][bj][m][0], v1 = acc[ai][bj][m][1];
                    u32x4 w; w.x = cvt_pk_bf16(v0[0], v0[1]); w.y = cvt_pk_bf16(v0[2], v0[3]); w.z = cvt_pk_bf16(v1[0], v1[1]); w.w = cvt_pk_bf16(v1[2], v1[3]);
                    *(u32x4*)(rowp + bj * HALF) = w; } }
    }
};

__device__ __forceinline__ float fast_sigmoid(float x) { return __builtin_amdgcn_rcpf(1.0f + __builtin_amdgcn_exp2f(-1.4426950408889634f * x)); }
struct EpiSwiglu {
    static constexpr bool PERM = true, AFTER_DRAIN = false;
    bf16_t* O; int ldc;
    __device__ __forceinline__ void operator()(const f32x4 (&acc)[2][2][4][2], const Unit& u, int wr, int wc, int fr, int fq) const {
        const int row0 = u.pm * BM + wr * 64 + fr, col0 = u.pn * HALF + wc * 32 + 8 * fq;
#pragma unroll
        for (int ai = 0; ai < 2; ++ai)
#pragma unroll
            for (int m = 0; m < 4; ++m) { bf16_t* rowp = O + (size_t)(row0 + ai * HALF + m * 16) * ldc + col0; f32x4 y[2];
#pragma unroll
                for (int n = 0; n < 2; ++n) { const f32x4 g = acc[ai][0][m][n], uu = acc[ai][1][m][n];
#pragma unroll
                    for (int i = 0; i < 4; ++i) y[n][i] = g[i] * fast_sigmoid(g[i]) * uu[i]; }
                u32x4 w; w.x = cvt_pk_bf16(y[0][0], y[0][1]); w.y = cvt_pk_bf16(y[0][2], y[0][3]); w.z = cvt_pk_bf16(y[1][0], y[1][1]); w.w = cvt_pk_bf16(y[1][2], y[1][3]);
                *(u32x4*)rowp = w; }
    }
};
struct EpiResid {
    static constexpr bool PERM = false, AFTER_DRAIN = false;
    float* H; int ldc; const float* gate; float gs;
    __device__ __forceinline__ void operator()(const f32x4 (&acc)[2][2][4][2], const Unit& u, int wr, int wc, int fr, int fq) const {
        const int row0 = u.pm * BM + wr * 64 + fr, col0 = u.pn * BM + wc * 32 + 4 * fq;
        f32x4 gv[2][2];
#pragma unroll
        for (int bj = 0; bj < 2; ++bj)
#pragma unroll
            for (int n = 0; n < 2; ++n) gv[bj][n] = *(const f32x4*)(gate + col0 + bj * HALF + n * 16) * gs;
#pragma unroll
        for (int ai = 0; ai < 2; ++ai)
#pragma unroll
            for (int m = 0; m < 4; ++m) { float* rowp = H + (size_t)(row0 + ai * HALF + m * 16) * ldc + col0;
#pragma unroll
                for (int bj = 0; bj < 2; ++bj)
#pragma unroll
                    for (int n = 0; n < 2; ++n) { f32x4* p = (f32x4*)(rowp + bj * HALF + n * 16); *p = *p + gv[bj][n] * acc[ai][bj][m][n]; }
                asm volatile("" ::: "memory"); }
    }
};
struct EpiIn {
    static constexpr bool PERM = true, AFTER_DRAIN = false;
    bf16_t* O; int ldc; const float* tab; int rope_rows, rope_tiles, gate_tile0;
    __device__ __forceinline__ void operator()(const f32x4 (&acc)[2][2][4][2], const Unit& u, int wr, int wc, int fr, int fq) const {
        const int row0 = u.pm * BM + wr * 64 + fr, col0 = u.pn * BM + wc * 32 + 8 * fq;
        const int mode = (u.pn < rope_tiles && u.pm * BM < rope_rows) ? 1 : (u.pn >= gate_tile0 ? 2 : 0);
        const int axis = wc >> 1, pi0 = 16 * (wc & 1) + 4 * fq;
#pragma unroll
        for (int ai = 0; ai < 2; ++ai)
#pragma unroll
            for (int m = 0; m < 4; ++m) { const int r = row0 + ai * HALF + m * 16; bf16_t* rowp = O + (size_t)r * ldc + col0;
                f32x4 cs0 = {1.f, 0.f, 1.f, 0.f}, cs1 = {1.f, 0.f, 1.f, 0.f};
                if (mode == 1) { const int pos = axis ? (r & 63) : (r >> 6); const float* tp = tab + (size_t)(pos * 32 + pi0) * 2; cs0 = *(const f32x4*)tp; cs1 = *(const f32x4*)(tp + 4); }
#pragma unroll
                for (int bj = 0; bj < 2; ++bj) { f32x4 v0 = acc[ai][bj][m][0], v1 = acc[ai][bj][m][1];
                    if (mode == 1) { const f32x4 t1 = v0, t2 = v1;
                        v0[0] = t1[0] * cs0[0] - t2[0] * cs0[1]; v1[0] = t2[0] * cs0[0] + t1[0] * cs0[1];
                        v0[1] = t1[1] * cs0[2] - t2[1] * cs0[3]; v1[1] = t2[1] * cs0[2] + t1[1] * cs0[3];
                        v0[2] = t1[2] * cs1[0] - t2[2] * cs1[1]; v1[2] = t2[2] * cs1[0] + t1[2] * cs1[1];
                        v0[3] = t1[3] * cs1[2] - t2[3] * cs1[3]; v1[3] = t2[3] * cs1[2] + t1[3] * cs1[3]; }
                    else if (mode == 2) {
#pragma unroll
                        for (int i = 0; i < 4; ++i) { v0[i] = fast_sigmoid(v0[i]); v1[i] = fast_sigmoid(v1[i]); } }
                    u32x4 w; w.x = cvt_pk_bf16(v0[0], v0[1]); w.y = cvt_pk_bf16(v0[2], v0[3]); w.z = cvt_pk_bf16(v1[0], v1[1]); w.w = cvt_pk_bf16(v1[2], v1[3]);
                    *(u32x4*)(rowp + bj * HALF) = w; } }
    }
};
struct EpiMerge {
    static constexpr bool PERM = true, AFTER_DRAIN = false;
    const bf16_t* G; int ldg; int gate_off; float* S; bf16_t* O; int ldc;
    __device__ __forceinline__ void operator()(const f32x4 (&acc)[2][2][4][2], const Unit& u, int wr, int wc, int fr, int fq) const {
        const int row0 = u.pm * BM + wr * 64 + fr, col0 = u.pn * BM + wc * 32 + 8 * fq; const int seg = u.seg;
#pragma unroll
        for (int ai = 0; ai < 2; ++ai)
#pragma unroll
            for (int m = 0; m < 4; ++m) { const int r = row0 + ai * HALF + m * 16;
#pragma unroll
                for (int bj = 0; bj < 2; ++bj) { const int c = col0 + bj * HALF;
                    const u32x4 gw = *(const u32x4*)(G + (size_t)r * ldg + gate_off + seg * ldc + c);
                    f32x4 g0, g1; g0[0] = __builtin_bit_cast(float, gw.x << 16); g0[1] = __builtin_bit_cast(float, gw.x & 0xffff0000u); g0[2] = __builtin_bit_cast(float, gw.y << 16); g0[3] = __builtin_bit_cast(float, gw.y & 0xffff0000u);
                    g1[0] = __builtin_bit_cast(float, gw.z << 16); g1[1] = __builtin_bit_cast(float, gw.z & 0xffff0000u); g1[2] = __builtin_bit_cast(float, gw.w << 16); g1[3] = __builtin_bit_cast(float, gw.w & 0xffff0000u);
                    f32x4 v0 = acc[ai][bj][m][0] * g0, v1 = acc[ai][bj][m][1] * g1; float* sp = S + (size_t)r * ldc + c;
                    if (seg > 0) { v0 += *(const f32x4*)sp; v1 += *(const f32x4*)(sp + 4); }
                    if (seg < 2) { *(f32x4*)sp = v0; *(f32x4*)(sp + 4) = v1; }
                    else { u32x4 w; w.x = cvt_pk_bf16(v0[0], v0[1]); w.y = cvt_pk_bf16(v0[2], v0[3]); w.z = cvt_pk_bf16(v1[0], v1[1]); w.w = cvt_pk_bf16(v1[2], v1[3]); *(u32x4*)(O + (size_t)r * ldc + c) = w; } }
                asm volatile("" ::: "memory"); }
    }
};
struct SegOrder : StaticOrder {
    __device__ __forceinline__ bool next(int i, Unit& u) const { const int t = i / 3; if (!StaticOrder::next(t, u)) return false; u.seg = i - 3 * t; return true; }
    __device__ __forceinline__ int koff(const Unit& u) const { return u.seg == 0 ? 0 : (u.seg == 1 ? 2048 : 3072); }
    __device__ __forceinline__ int nt(const Unit& u) const { return u.seg == 0 ? 32 : 16; }
};

template <class Epi, class Sched, bool ALIGN_EPI = false, bool SP2 = false>
__device__ __forceinline__ void gemm_phase(PG8_LAS unsigned char* lds, const Gemm g, const Sched& S, const Epi& E, int tid_in) {
    int tid_ = tid_in; asm volatile("" : "+v"(tid_));
    const int tid = tid_, wid = __builtin_amdgcn_readfirstlane(tid >> 6), lane = tid & 63, wr = wid >> 2, wc = wid & 3, fr = lane & 15, fq = lane >> 4;
    int K_ = g.K; asm volatile("" : "+s"(K_)); const int K = K_; int nt;
    unsigned voffA[2], voffB[2];
#pragma unroll
    for (int i = 0; i < 2; ++i) { int R, C; stage_rc(tid * 16 + i * 8192, R, C); const int Rb = Epi::PERM ? ((R & ~31) + perm32(R & 31)) : R;
        voffA[i] = (unsigned)(R * K + C) * 2u; voffB[i] = (unsigned)(Rb * K + C) * 2u; }
    const size_t kstep = (size_t)(BK * 2);
    const size_t hstep = (size_t)HALF * K * 2;
    const size_t tstep = 2 * hstep;
    const unsigned ldsw = (unsigned)wid * 1024u;
    const int aoff = lds_byte(wr * 64 + fr, fq * 8), boff = lds_byte(wc * 32 + fr, fq * 8);
#define PG8_SA(b, h) (((b) * 2 + (h)) * HTB)
#define PG8_SB(b, h) ((4 + (b) * 2 + (h)) * HTB)
#define PG8_STAGE(bufoff, gbase, voff) do { _Pragma("unroll") for (int _i = 0; _i < 2; ++_i) \
        __builtin_amdgcn_global_load_lds((const unsigned*)((const char*)(gbase) + (voff)[_i]), (PG8_LAS unsigned*)(lds + (bufoff) + ldsw + _i * 8192), 16, 0, 0); } while (0)
#define PG8_LDA(dst, b, h) do { _Pragma("unroll") for (int m = 0; m < 4; ++m) _Pragma("unroll") for (int k = 0; k < 2; ++k) dst[m][k] = *(const PG8_LAS bf16x8*)(lds + PG8_SA(b, h) + aoff + m * 2048 + k * 1024); } while (0)
#define PG8_LDB(dst, b, h) do { _Pragma("unroll") for (int n = 0; n < 2; ++n) _Pragma("unroll") for (int k = 0; k < 2; ++k) dst[n][k] = *(const PG8_LAS bf16x8*)(lds + PG8_SB(b, h) + boff + n * 2048 + k * 1024); } while (0)
#define PG8_MMA(ai, bj, At, Bt) do { __builtin_amdgcn_s_setprio(1); _Pragma("unroll") for (int m = 0; m < 4; ++m) _Pragma("unroll") for (int n = 0; n < 2; ++n) _Pragma("unroll") for (int k = 0; k < 2; ++k) \
        acc[ai][bj][m][n] = __builtin_amdgcn_mfma_f32_16x16x32_bf16(Bt[n][k], At[m][k], acc[ai][bj][m][n], 0, 0, 0); __builtin_amdgcn_s_setprio(0); } while (0)
#define PG8_WAIT_V(n) asm volatile("s_waitcnt vmcnt(" #n ")" ::: "memory")
#define PG8_WAIT_L(n) asm volatile("s_waitcnt lgkmcnt(" #n ")" ::: "memory")
#define PG8_BAR __builtin_amdgcn_s_barrier()
#define PG8_SCHED __builtin_amdgcn_sched_barrier(0)
    Unit cur, nxt; int ui = 0;
    if (!S.next(0, cur)) return;
    f32x4 acc[2][2][4][2];
#pragma unroll
    for (int a = 0; a < 2; ++a)
#pragma unroll
        for (int b = 0; b < 2; ++b)
#pragma unroll
            for (int m = 0; m < 4; ++m)
#pragma unroll
                for (int n = 0; n < 2; ++n) acc[a][b][m][n] = (f32x4){0.f, 0.f, 0.f, 0.f};
    bf16x8 At[4][2], B0[2][2], B1[2][2];
    const char* cA = (const char*)g.A + (size_t)cur.pm * tstep + (size_t)S.koff(cur) * 2; const char* cB = (const char*)g.Bt + (size_t)cur.pn * tstep + (size_t)S.koff(cur) * 2; nt = S.nt(cur);
    S.a_ready(cur);
    if constexpr (SP2) {
        PG8_STAGE(PG8_SB(0, 0), cB, voffB); PG8_STAGE(PG8_SB(0, 1), cB + hstep, voffB); PG8_STAGE(PG8_SA(0, 0), cA, voffA); PG8_STAGE(PG8_SA(0, 1), cA + hstep, voffA);
        if (wr == 1) PG8_BAR;
        PG8_WAIT_V(2); PG8_BAR;
        PG8_STAGE(PG8_SB(1, 0), cB + kstep, voffB); PG8_STAGE(PG8_SA(1, 0), cA + kstep, voffA); PG8_STAGE(PG8_SB(1, 1), cB + hstep + kstep, voffB);
        PG8_WAIT_V(6); PG8_BAR;
    } else {
        PG8_STAGE(PG8_SB(0, 0), cB, voffB); PG8_STAGE(PG8_SA(0, 0), cA, voffA); PG8_STAGE(PG8_SB(0, 1), cB + hstep, voffB); PG8_STAGE(PG8_SA(0, 1), cA + hstep, voffA);
        if (wr == 1) PG8_BAR;
        PG8_WAIT_V(4); PG8_BAR;
        PG8_STAGE(PG8_SB(1, 0), cB + kstep, voffB); PG8_STAGE(PG8_SA(1, 0), cA + kstep, voffA); PG8_STAGE(PG8_SB(1, 1), cB + hstep + kstep, voffB);
        PG8_WAIT_V(6); PG8_BAR;
    }
    for (;;) {
        const bool has_next = S.next(ui + 1, nxt);
        const char* nA = has_next ? (const char*)g.A + (size_t)nxt.pm * tstep + (size_t)S.koff(nxt) * 2 : cA; const char* nB = has_next ? (const char*)g.Bt + (size_t)nxt.pn * tstep + (size_t)S.koff(nxt) * 2 : cB;
        for (int t = 0; t < nt; t += 2) {
            const bool last = (t == nt - 2);
            const char* a1 = cA + (size_t)(t + 1) * kstep;
            const char* a2 = last ? nA : cA + (size_t)(t + 2) * kstep; const char* b2 = last ? nB : cB + (size_t)(t + 2) * kstep;
            const char* a3 = a2 + kstep; const char* b3 = b2 + kstep;
            if (last && has_next) S.a_ready(nxt);
            if constexpr (SP2) {
            PG8_LDB(B0, 0, 0); PG8_LDB(B1, 0, 1); PG8_SCHED; PG8_LDA(At, 0, 0); PG8_STAGE(PG8_SA(1, 1), a1 + hstep, voffA);
            PG8_WAIT_V(8); PG8_WAIT_L(0); PG8_BAR; PG8_MMA(0, 0, At, B0); PG8_MMA(0, 1, At, B1); PG8_BAR; PG8_SCHED;
            PG8_LDA(At, 0, 1); PG8_STAGE(PG8_SB(0, 0), b2, voffB); PG8_STAGE(PG8_SB(0, 1), b2 + hstep, voffB); PG8_STAGE(PG8_SA(0, 0), a2, voffA);
            PG8_WAIT_V(8); PG8_WAIT_L(0); PG8_BAR; PG8_MMA(1, 0, At, B0); PG8_MMA(1, 1, At, B1); PG8_BAR; PG8_SCHED;
            PG8_LDB(B0, 1, 0); PG8_LDB(B1, 1, 1); PG8_SCHED; PG8_LDA(At, 1, 0); PG8_STAGE(PG8_SA(0, 1), a2 + hstep, voffA);
            PG8_WAIT_V(8); PG8_WAIT_L(0); PG8_BAR; PG8_MMA(0, 0, At, B0); PG8_MMA(0, 1, At, B1); PG8_BAR; PG8_SCHED;
            PG8_LDA(At, 1, 1); PG8_STAGE(PG8_SB(1, 0), b3, voffB); PG8_STAGE(PG8_SB(1, 1), b3 + hstep, voffB); PG8_STAGE(PG8_SA(1, 0), a3, voffA);
            PG8_WAIT_V(8); PG8_WAIT_L(0); PG8_BAR; PG8_MMA(1, 0, At, B0); PG8_MMA(1, 1, At, B1); PG8_BAR; PG8_SCHED;
            } else {
            PG8_LDB(B0, 0, 0); PG8_SCHED; PG8_LDA(At, 0, 0); PG8_STAGE(PG8_SA(1, 1), a1 + hstep, voffA);
            PG8_WAIT_L(8); PG8_BAR; PG8_WAIT_L(0); PG8_MMA(0, 0, At, B0); PG8_BAR; PG8_SCHED;
            PG8_LDB(B1, 0, 1); PG8_STAGE(PG8_SB(0, 0), b2, voffB);
            PG8_BAR; PG8_WAIT_L(0); PG8_MMA(0, 1, At, B1); PG8_BAR;
            PG8_LDA(At, 0, 1); PG8_STAGE(PG8_SA(0, 0), a2, voffA);
            PG8_BAR; PG8_WAIT_L(0); PG8_MMA(1, 0, At, B0); PG8_BAR; PG8_SCHED;
            PG8_STAGE(PG8_SB(0, 1), b2 + hstep, voffB);
            PG8_WAIT_V(6); PG8_BAR; PG8_MMA(1, 1, At, B1); PG8_BAR;
            PG8_LDB(B0, 1, 0); PG8_SCHED; PG8_LDA(At, 1, 0); PG8_STAGE(PG8_SA(0, 1), a2 + hstep, voffA);
            PG8_WAIT_L(8); PG8_BAR; PG8_WAIT_L(0); PG8_MMA(0, 0, At, B0); PG8_BAR; PG8_SCHED;
            PG8_LDB(B1, 1, 1); PG8_STAGE(PG8_SB(1, 0), b3, voffB);
            PG8_BAR; PG8_WAIT_L(0); PG8_MMA(0, 1, At, B1); PG8_BAR;
            PG8_LDA(At, 1, 1); PG8_STAGE(PG8_SA(1, 0), a3, voffA);
            PG8_BAR; PG8_WAIT_L(0); PG8_MMA(1, 0, At, B0); PG8_BAR; PG8_SCHED;
            PG8_STAGE(PG8_SB(1, 1), b3 + hstep, voffB);
            PG8_WAIT_V(6); PG8_BAR; PG8_MMA(1, 1, At, B1); PG8_BAR;
            }
        }
        if constexpr (ALIGN_EPI) { if (wr == 0) PG8_BAR; }
        if constexpr (!Epi::AFTER_DRAIN) { E(acc, cur, wr, wc, fr, fq); S.done(cur); }
        if (!has_next) break;
#pragma unroll
        for (int a = 0; a < 2; ++a)
#pragma unroll
            for (int b = 0; b < 2; ++b)
#pragma unroll
                for (int m = 0; m < 4; ++m)
#pragma unroll
                    for (int n = 0; n < 2; ++n) acc[a][b][m][n] = (f32x4){0.f, 0.f, 0.f, 0.f};
        cur = nxt; cA = nA; cB = nB; ++ui; nt = S.nt(cur);
        if constexpr (ALIGN_EPI) { if (wr == 1) PG8_BAR; }
    }
    PG8_WAIT_V(0);
    if constexpr (!ALIGN_EPI) { if (wr == 0) PG8_BAR; }
    PG8_BAR;
    if constexpr (Epi::AFTER_DRAIN) { E.fused(acc, cur, wr, wc, fr, fq, lds, wid, lane); S.done(cur); }
#undef PG8_SA
#undef PG8_SB
#undef PG8_STAGE
#undef PG8_LDA
#undef PG8_LDB
#undef PG8_MMA
#undef PG8_WAIT_V
#undef PG8_WAIT_L
#undef PG8_BAR
#undef PG8_SCHED
}
}


namespace att {
typedef unsigned short bf16;
constexpr int D = 128, NW = 8, QBLK = 32, KVBLK = 64;
constexpr float SCALE = 0.088388347648318440f;
constexpr float THR = 8.f;
constexpr int SDEPTH = 1;
constexpr size_t SHM_V = KVBLK * D * 2, SHM_K = KVBLK * D * 2, SHM_ATTN = 2 * SHM_V + 2 * SHM_K + NW * 64 * 4;
using bf16x8 = __attribute__((ext_vector_type(8))) short;
using s16x4  = __attribute__((ext_vector_type(4))) short;
using f32x16 = __attribute__((ext_vector_type(16))) float;
using u32x4  = __attribute__((ext_vector_type(4))) unsigned;
#define KSWZ(row, colB) ((row) * 256 + ((colB) ^ (((row) & 7) << 4)))
#define SBAR() __builtin_amdgcn_sched_barrier(0)
__device__ __forceinline__ int crow(int r, int hi) { return (r & 3) + 8 * (r >> 2) + 4 * hi; }
__device__ __forceinline__ unsigned cvtpk(float lo, float hi) {
  unsigned r; asm volatile("v_cvt_pk_bf16_f32 %0, %1, %2" : "=v"(r) : "v"(lo), "v"(hi)); return r;
}
__device__ __forceinline__ void partialSM(f32x16& p0, f32x16& p1, float& m_reg, float& mn, float& alpha) {
  constexpr float C = SCALE * 1.4426950408889634f;
  float pmax = p0[0]; for (int r = 1; r < 16; ++r) pmax = fmaxf(pmax, p0[r]); for (int r = 0; r < 16; ++r) pmax = fmaxf(pmax, p1[r]);
  { auto rr = __builtin_amdgcn_permlane32_swap(__float_as_uint(pmax), __float_as_uint(pmax), false, false);
    pmax = fmaxf(__uint_as_float(rr[0]), __uint_as_float(rr[1])); }
  if (__builtin_expect(__all(pmax - m_reg <= THR / SCALE), 1)) { mn = m_reg; alpha = 1.f; }
  else { mn = fmaxf(m_reg, pmax); alpha = __builtin_amdgcn_exp2f((m_reg - mn) * C); m_reg = mn; }
  float mnC = -mn * C;
  for (int r = 0; r < 16; ++r) p0[r] = fmaf(p0[r], C, mnC); for (int r = 0; r < 16; ++r) p1[r] = fmaf(p1[r], C, mnC);
  for (int r = 0; r < 16; ++r) p0[r] = __builtin_amdgcn_exp2f(p0[r]);
}
__device__ __forceinline__ void finishSM(f32x16& p0, f32x16& p1, float alpha, float& l_reg, bf16x8& pa0, bf16x8& pa1, bf16x8& pa2, bf16x8& pa3) {
  for (int r = 0; r < 16; ++r) p1[r] = __builtin_amdgcn_exp2f(p1[r]);
  float ps = 0; for (int r = 0; r < 16; ++r) ps += p0[r]; for (int r = 0; r < 16; ++r) ps += p1[r];
  { auto rr = __builtin_amdgcn_permlane32_swap(__float_as_uint(ps), __float_as_uint(ps), false, false);
    ps = __uint_as_float(rr[0]) + __uint_as_float(rr[1]); }
  l_reg = l_reg * alpha + ps;
#define PK4(P, BASE, OUT) do { unsigned a0 = cvtpk(P[BASE + 0], P[BASE + 1]), a1 = cvtpk(P[BASE + 2], P[BASE + 3]);   \
    unsigned b0 = cvtpk(P[BASE + 4], P[BASE + 5]), b1 = cvtpk(P[BASE + 6], P[BASE + 7]);                              \
    auto r0 = __builtin_amdgcn_permlane32_swap(a0, b0, false, false); auto r1 = __builtin_amdgcn_permlane32_swap(a1, b1, false, false); \
    u32x4 w = {r0[0], r1[0], r0[1], r1[1]}; OUT = *reinterpret_cast<bf16x8*>(&w); } while (0)
  PK4(p0, 0, pa0); PK4(p0, 8, pa1); PK4(p1, 0, pa2); PK4(p1, 8, pa3);
#undef PK4
}
__device__ __forceinline__ void qkt(f32x16& p0, f32x16& p1, const bf16* Ks, const bf16x8* qr, int r32, int hi) {
  p0 = f32x16{}; p1 = f32x16{};
  for (int d0 = 0; d0 < 8; ++d0) { int cb = (d0 * 16 + hi * 8) * 2;
    bf16x8 b0 = *reinterpret_cast<const bf16x8*>((const char*)Ks + KSWZ(r32, cb));
    bf16x8 b1 = *reinterpret_cast<const bf16x8*>((const char*)Ks + KSWZ(32 + r32, cb));
    p0 = __builtin_amdgcn_mfma_f32_32x32x16_bf16(b0, qr[d0], p0, 0, 0, 0);
    p1 = __builtin_amdgcn_mfma_f32_32x32x16_bf16(b1, qr[d0], p1, 0, 0, 0); }
}
__device__ __forceinline__ int v_st(int k, int c) { const int kk = (k & ~0xC) | ((k & 4) << 1) | ((k & 8) >> 1); return ((kk >> 3) * 4 + (c >> 5)) * 512 + ((kk & 7) * 32 + (c & 31)) * 2; }
__device__ __forceinline__ int v_rd_base(int lane) { return ((lane & 3) << 3) | (((lane >> 2) & 3) << 6) | (((lane >> 4) & 1) << 5) | (((lane >> 5) & 1) << 8); }
constexpr int v_rd_off(int d0, int ks, int half) { return d0 * 512 + ks * 4096 + half * 2048; }
template <int OFF> __device__ __forceinline__ s16x4 tr_read(int vb) {
  s16x4 r; asm volatile("ds_read_b64_tr_b16 %0, %1 offset:%2" : "=&v"(r) : "v"(vb), "i"(OFF) : "memory"); return r;
}
template <int D0> __device__ __forceinline__ void pv_one(f32x16& od, int vb, bf16x8 pa0, bf16x8 pa1, bf16x8 pa2, bf16x8 pa3) {
  const s16x4 l0 = tr_read<v_rd_off(D0, 0, 0)>(vb), h0 = tr_read<v_rd_off(D0, 0, 1)>(vb), l1 = tr_read<v_rd_off(D0, 1, 0)>(vb), h1 = tr_read<v_rd_off(D0, 1, 1)>(vb);
  const s16x4 l2 = tr_read<v_rd_off(D0, 2, 0)>(vb), h2 = tr_read<v_rd_off(D0, 2, 1)>(vb), l3 = tr_read<v_rd_off(D0, 3, 0)>(vb), h3 = tr_read<v_rd_off(D0, 3, 1)>(vb);
  asm volatile("s_waitcnt lgkmcnt(0)" ::: "memory"); SBAR();
#define PK(L, H) (bf16x8){L[0], L[1], L[2], L[3], H[0], H[1], H[2], H[3]}
  od = __builtin_amdgcn_mfma_f32_32x32x16_bf16(pa0, PK(l0, h0), od, 0, 0, 0);
  od = __builtin_amdgcn_mfma_f32_32x32x16_bf16(pa1, PK(l1, h1), od, 0, 0, 0);
  od = __builtin_amdgcn_mfma_f32_32x32x16_bf16(pa2, PK(l2, h2), od, 0, 0, 0);
  od = __builtin_amdgcn_mfma_f32_32x32x16_bf16(pa3, PK(l3, h3), od, 0, 0, 0);
#undef PK
}
__device__ __forceinline__ void pv_d0(f32x16* o, int vb, bf16x8 pa0, bf16x8 pa1, bf16x8 pa2, bf16x8 pa3) {
  pv_one<0>(o[0], vb, pa0, pa1, pa2, pa3); pv_one<1>(o[1], vb, pa0, pa1, pa2, pa3); pv_one<2>(o[2], vb, pa0, pa1, pa2, pa3); pv_one<3>(o[3], vb, pa0, pa1, pa2, pa3);
}


__device__ __forceinline__ void band_mask(f32x16& p0, f32x16& p1, int kind, int off, int i, int hi) {
  const int th = i - off - 4 * hi;
  if (kind == 1) {
#pragma unroll
    for (int r = 0; r < 16; ++r) { const int k0 = (r & 3) + 8 * (r >> 2); p0[r] = (k0 < th) ? -1e30f : p0[r]; p1[r] = (32 + k0 < th) ? -1e30f : p1[r]; } }
  else if (kind == 2) {
#pragma unroll
    for (int r = 0; r < 16; ++r) { const int k0 = (r & 3) + 8 * (r >> 2); p0[r] = (k0 > th) ? -1e30f : p0[r]; p1[r] = (32 + k0 > th) ? -1e30f : p1[r]; } }
}
constexpr int NQB = 64, LROWS = 8192;
__device__ __forceinline__ void tile_info(int qb, int t, int& row, int& kind, int& off) {
  kind = 0; off = 0;
  if (qb >= NQB) { row = LROWS + 64 * t; return; }
  if (t < 2) { row = qb * 128 + 64 * t; return; }
  if (t < 6) { row = LROWS + 64 * (t - 2); return; }
  int tt = t - 6; const bool prev = (qb > 0) && (tt < 2); if (!prev && qb > 0) tt -= 2;
  off = 64 * tt; if (prev) { row = (qb - 1) * 128 + off; kind = 1; } else { row = (qb + 1) * 128 + off; kind = 2; }
}
__device__ __forceinline__ void attn_unit(const bf16* __restrict__ P, int ldp, int qoff, int koff, int voff, bf16* __restrict__ O, int ldo, int qb, int kvh, int hq0, const float* __restrict__ sink, char* lds, int tid) {
  const int wid = __builtin_amdgcn_readfirstlane(tid >> 6), lane = tid & 63, r32 = lane & 31, hi = lane >> 5;
  const int hq = hq0 + (wid >> 2), iq = (wid & 3) * 32 + r32;
  bf16* V_lds = (bf16*)lds; bf16* K_lds = (bf16*)(lds + 2 * SHM_V);
  float* ws = (float*)(lds + 2 * SHM_V + 2 * SHM_K) + wid * 64; float* li_l = ws; float* al_l = ws + 32;
  float m_reg = -1e30f, l_reg = 0; f32x16 o[4] = {}; bf16x8 qr[8];
  const bf16* Qw = P + (size_t)(qb * 128 + iq) * ldp + qoff + hq * 128 + hi * 8;
#pragma unroll
  for (int d0 = 0; d0 < 8; ++d0) qr[d0] = *reinterpret_cast<const bf16x8*>(Qw + d0 * 16);
  const int sr = tid >> 4, sc = (tid & 15) * 8, vst0 = v_st(sr, sc), vst1 = v_st(32 + sr, sc);
  const int vb0 = (int)(uintptr_t)V_lds + v_rd_base(lane);
  const bf16* Kg = P + koff + kvh * 128 + sc; const bf16* Vg = P + voff + kvh * 128 + sc;
  struct { bf16x8 vs0, vs1, ks0, ks1; } sr_[SDEPTH];
  const int NT = (qb >= NQB) ? 4 : 6 + (qb > 0 ? 2 : 0) + (qb < NQB - 1 ? 2 : 0);
  int trow, tkind, toff;
#define SLOAD(i, t) do { int kd_, of_; tile_info(qb, (t), trow, kd_, of_); const unsigned r0_ = (unsigned)(trow + sr) * (unsigned)ldp, r1_ = r0_ + 32u * (unsigned)ldp; \
    sr_[i].vs0 = *reinterpret_cast<const bf16x8*>(Vg + r0_); sr_[i].vs1 = *reinterpret_cast<const bf16x8*>(Vg + r1_); \
    sr_[i].ks0 = *reinterpret_cast<const bf16x8*>(Kg + r0_); sr_[i].ks1 = *reinterpret_cast<const bf16x8*>(Kg + r1_); } while (0)
#define SWRITE(b, i) do { *(bf16x8*)((char*)V_lds + (b) * SHM_V + vst0) = sr_[i].vs0;          \
    *(bf16x8*)((char*)V_lds + (b) * SHM_V + vst1) = sr_[i].vs1; int kc = sc * 2;               \
    *(bf16x8*)((char*)K_lds + (b) * SHM_K + KSWZ(sr, kc)) = sr_[i].ks0;                       \
    *(bf16x8*)((char*)K_lds + (b) * SHM_K + KSWZ(32 + sr, kc)) = sr_[i].ks1; } while (0)
#define SWAIT() do { if constexpr (SDEPTH == 2) asm volatile("s_waitcnt vmcnt(4)" ::: "memory"); else asm volatile("s_waitcnt vmcnt(0)" ::: "memory"); } while (0)
#define RESC(a) do { if (__any((a) < 1.f)) { if (hi == 0) al_l[r32] = (a); asm volatile("s_waitcnt lgkmcnt(0)" ::: "memory"); \
    for (int d = 0; d < 4; ++d) for (int r = 0; r < 16; ++r) o[d][r] *= al_l[crow(r, hi)]; } } while (0)
#define MASK(p0, p1, t) do { tile_info(qb, (t), trow, tkind, toff); if (tkind) band_mask(p0, p1, tkind, toff, iq, hi); } while (0)
  f32x16 pA0, pA1, pB0, pB1; float mnA, mnB, alA, alB; bf16x8 pa0, pa1, pa2, pa3;
  constexpr int SE = 0, SO = SDEPTH - 1;
  SLOAD(SE, 0); asm volatile("s_waitcnt vmcnt(0)" ::: "memory"); SWRITE(0, SE); __syncthreads();
  qkt(pA0, pA1, K_lds, qr, r32, hi); partialSM(pA0, pA1, m_reg, mnA, alA);
  SLOAD(SO, 1); if constexpr (SDEPTH == 2) { if (2 < NT) SLOAD(SE, 2); }
  SWAIT(); SWRITE(1, SO); __syncthreads();
  for (int j = 1; j + 1 < NT; j += 2) {
    SBAR(); qkt(pB0, pB1, (bf16*)((char*)K_lds + SHM_K), qr, r32, hi); MASK(pB0, pB1, j);
    finishSM(pA0, pA1, alA, l_reg, pa0, pa1, pa2, pa3); SBAR();
    SLOAD(SO, j + SDEPTH); SBAR();
    pv_d0(o, vb0, pa0, pa1, pa2, pa3); partialSM(pB0, pB1, m_reg, mnB, alB);
    __syncthreads(); SWAIT(); SWRITE(0, SE);
    RESC(alB); __syncthreads();
    SBAR(); qkt(pA0, pA1, K_lds, qr, r32, hi); MASK(pA0, pA1, j + 1);
    finishSM(pB0, pB1, alB, l_reg, pa0, pa1, pa2, pa3); SBAR();
    if (SDEPTH == 1 || j + 3 < NT) SLOAD(SE, j + 1 + SDEPTH); SBAR();
    pv_d0(o, vb0 + (int)SHM_V, pa0, pa1, pa2, pa3); partialSM(pA0, pA1, m_reg, mnA, alA);
    __syncthreads(); SWAIT(); SWRITE(1, SO);
    RESC(alA); __syncthreads();
  }
  SBAR(); qkt(pB0, pB1, (bf16*)((char*)K_lds + SHM_K), qr, r32, hi); MASK(pB0, pB1, NT - 1);
  finishSM(pA0, pA1, alA, l_reg, pa0, pa1, pa2, pa3); SBAR();
  pv_d0(o, vb0, pa0, pa1, pa2, pa3); partialSM(pB0, pB1, m_reg, mnB, alB);
  __syncthreads(); RESC(alB);
  finishSM(pB0, pB1, alB, l_reg, pa0, pa1, pa2, pa3); SBAR();
  pv_d0(o, vb0 + (int)SHM_V, pa0, pa1, pa2, pa3);
  { constexpr float C = SCALE * 1.4426950408889634f; l_reg += __builtin_amdgcn_exp2f(sink[hq] * 1.4426950408889634f - m_reg * C); }
  if (hi == 0) li_l[r32] = l_reg; asm volatile("s_waitcnt lgkmcnt(0)" ::: "memory");
  float rli[16];
#pragma unroll
  for (int r = 0; r < 16; ++r) rli[r] = __builtin_amdgcn_rcpf(li_l[crow(r, hi)]);
  bf16* Ow = O + (size_t)(qb * 128 + (wid & 3) * 32) * ldo + hq * 128;
#pragma unroll
  for (int r = 0; r < 16; ++r) { const int orow = crow(r, hi);
#pragma unroll
    for (int d0 = 0; d0 < 4; ++d0) { const float v = o[d0][r] * rli[r]; unsigned u = __builtin_bit_cast(unsigned, v); u = (u + 0x7fffu + ((u >> 16) & 1u)) >> 16; Ow[(size_t)orow * ldo + d0 * 32 + r32] = (bf16)u; } }
#undef SLOAD
#undef SWRITE
#undef SWAIT
#undef RESC
#undef MASK
}
#undef KSWZ
#undef SBAR
}

constexpr int NWAVES = 8;
constexpr int D = 2048, L = 8192, LC = 256, MALL = L + LC, FF = 5632, NIN = 13312, NMOD = 9;
constexpr int HD = 128, NQH = 16, NKVH = 4;
constexpr int Q_OFF = 0, K_OFF = 2048, V_OFF = 2560, POOL_OFF = 3072, CB_OFF = 4096, CC_OFF = 5120, CX_OFF = 6144, GATE_OFF = 7168;
constexpr int KCAT = 4096;
constexpr float EPS = 1e-6f;
constexpr int NLAYER = 2, NPL = 11, NPHASE = 1 + NLAYER * NPL + 1;

constexpr size_t MiB = 1u << 20;
constexpr size_t WS_CTL = 0, CTL_ZERO_BYTES = 1 * MiB;
constexpr size_t WS_MODS = 1 * MiB;
constexpr size_t WS_ROPE = 1 * MiB + 512 * 1024;
constexpr size_t WS_W = 2 * MiB, W_LAYER = 208 * MiB;
constexpr size_t W_WI1 = 0, W_WO1 = 44 * MiB, W_WIN = 66 * MiB, W_WMRG = 118 * MiB, W_WOUT = 134 * MiB, W_WI2 = 142 * MiB, W_WO2 = 186 * MiB;
constexpr size_t WS_H = 418 * MiB;
constexpr size_t WS_XN = 484 * MiB;
constexpr size_t WS_ACT = 517 * MiB;
constexpr size_t WS_P = 608 * MiB;
constexpr size_t WS_ACAT = 823 * MiB;
constexpr size_t WS_Y3 = 889 * MiB;
constexpr size_t WS_MRG = 988 * MiB;
constexpr size_t WS_C = 1021 * MiB;
constexpr size_t WS_END = 1087 * MiB;
static_assert((size_t)MALL * NIN * 2 <= 215 * MiB && (size_t)MALL * FF * 2 <= 91 * MiB && (size_t)MALL * D * 4 <= 66 * MiB && (size_t)MALL * D * 2 <= 33 * MiB, "d_ws map");
constexpr int CW_Q = 1024;
constexpr int CW_BAR = 4096;

constexpr int RING_OFF = 0, RING_BYTES = 131072;
constexpr int LDSCTL_OFF = RING_BYTES, MISC_OFF = LDSCTL_OFF + 320;
constexpr int LDS_BYTES = 147456;

#define GAS __attribute__((address_space(1)))
#define LAS __attribute__((address_space(3)))
typedef unsigned short bf16;
typedef unsigned v4u __attribute__((ext_vector_type(4)));
typedef unsigned v2u __attribute__((ext_vector_type(2)));
typedef float f32x4 __attribute__((ext_vector_type(4)));
typedef float f32x2 __attribute__((ext_vector_type(2)));
typedef GAS unsigned gu32;
#define RLX_AGENT __ATOMIC_RELAXED, __HIP_MEMORY_SCOPE_AGENT
#define LDS_WAIT() asm volatile("s_waitcnt lgkmcnt(0)" ::: "memory")
#define VM_WAIT() asm volatile("s_waitcnt vmcnt(0)" ::: "memory")
__device__ __forceinline__ unsigned f2bf(float f) { unsigned u = __builtin_bit_cast(unsigned, f); return (u + 0x7fffu + ((u >> 16) & 1u)) >> 16; }
__device__ __forceinline__ unsigned pk2(float lo, float hi) { return f2bf(lo) | (f2bf(hi) << 16); }
__device__ __forceinline__ float bflo(unsigned w) { return __builtin_bit_cast(float, w << 16); }
__device__ __forceinline__ float bfhi(unsigned w) { return __builtin_bit_cast(float, w & 0xffff0000u); }
__device__ __forceinline__ float bf2f(bf16 b) { return __builtin_bit_cast(float, (unsigned)b << 16); }
__device__ __forceinline__ float sigmoidf_(float x) { return 1.0f / (1.0f + __expf(-x)); }
__device__ __forceinline__ float siluf_(float x) { return x / (1.0f + __expf(-x)); }

#define XB_TMO      128
#define XB_XCNT(j)  (256  + 64 * (j))
#define XB_XSUB(j)  (1280 + 64 * (j))
#define XB_XGEN(j)  (2304 + 64 * (j))
#define XB_TOP      3328
#define XB_TOPGEN   3392
#define XCD_BAR_WORDS 3456
#define XB_SPIN_CAP (1u << 18)

__device__ __forceinline__ unsigned xb_ld(unsigned* p)              { return __hip_atomic_load(p, __ATOMIC_RELAXED, __HIP_MEMORY_SCOPE_AGENT); }
__device__ __forceinline__ unsigned xb_add(unsigned* p, unsigned v) { return __hip_atomic_fetch_add(p, v, __ATOMIC_RELAXED, __HIP_MEMORY_SCOPE_AGENT); }
__device__ __forceinline__ unsigned xb_xcc_id() { return (unsigned)__builtin_amdgcn_s_getreg((3 << 11) | 20) & 0xFu; }
#define XB_SPIN(cond, bar) do { unsigned _sp = 0; while (cond) { __builtin_amdgcn_s_sleep(1); \
    if ((++_sp & 255u) == 0u) { if (xb_ld(&(bar)[XB_TMO])) break; if (_sp > XB_SPIN_CAP) { atomicAdd(&(bar)[XB_TMO], 1u); break; } } } } while (0)

struct XcdBarrier {
    unsigned* bar; unsigned x;
    volatile LAS unsigned* st;
};

__device__ __forceinline__ XcdBarrier xcd_barrier_post(unsigned* bar, volatile LAS unsigned* st, int tid) {
    XcdBarrier b; b.bar = bar; b.x = xb_xcc_id(); b.st = st;
    if (tid == 0) (void)xb_add(&bar[XB_XCNT(b.x)], 1u);
    return b;
}
__device__ __forceinline__ void xcd_barrier_complete(unsigned* bar, unsigned x, unsigned& nloc, unsigned& nx) {
    const unsigned G = gridDim.x * gridDim.y * gridDim.z;
    unsigned sum, cnt, mine, sp = 0u;
    for (;;) {
        sum = 0u; cnt = 0u; mine = 0u;
#pragma unroll
        for (unsigned j = 0; j < 16; ++j) { const unsigned c = xb_ld(&bar[XB_XCNT(j)]); sum += c; cnt += (c > 0u) ? 1u : 0u; mine = (j == x) ? c : mine; }
        if (sum == G) break;
        __builtin_amdgcn_s_sleep(1);
        if ((++sp & 255u) == 0u) { if (xb_ld(&bar[XB_TMO])) break; if (sp > XB_SPIN_CAP) { atomicAdd(&bar[XB_TMO], 1u); break; } }
    }
    nloc = mine > 0u ? mine : 1u; nx = cnt > 0u ? cnt : 1u;
}

__device__ __forceinline__ void xcd_barrier(const XcdBarrier& b, int tid) {
    asm volatile("s_waitcnt vmcnt(0)" ::: "memory");
    __syncthreads();
    if (tid == 0) {
        unsigned* bar = b.bar;
        __builtin_amdgcn_s_waitcnt(0);
        unsigned nloc = b.st[0], nx = b.st[1];
        if (nloc == 0u) { xcd_barrier_complete(bar, b.x, nloc, nx); b.st[0] = nloc; b.st[1] = nx; }
        const unsigned old = xb_add(&bar[XB_XSUB(b.x)], 1u);
        const unsigned gen = old / nloc;
        if (old + 1u == (gen + 1u) * nloc) {
            __builtin_amdgcn_fence(__ATOMIC_RELEASE, "agent");
            asm volatile("s_waitcnt vmcnt(0)" ::: "memory");
            const unsigned og = xb_add(&bar[XB_TOP], 1u);
            const unsigned tg = og / nx;
            if (og + 1u == (tg + 1u) * nx) xb_add(&bar[XB_TOPGEN], 1u);
            else XB_SPIN(xb_ld(&bar[XB_TOPGEN]) == tg, bar);
            __builtin_amdgcn_fence(__ATOMIC_ACQUIRE, "agent");
            xb_add(&bar[XB_XGEN(b.x)], 1u);
            asm volatile("s_waitcnt vmcnt(0)" ::: "memory");
        } else {
            XB_SPIN(xb_ld(&bar[XB_XGEN(b.x)]) == gen, bar);
            __builtin_amdgcn_fence(__ATOMIC_ACQUIRE, "agent");
            asm volatile("s_waitcnt vmcnt(0)" ::: "memory");
        }
    }
    __syncthreads();
}


struct Args { const float* in[21]; float* out; unsigned char* ws; int ph_lo, ph_hi; };
struct Frame {
    LAS unsigned char* lds;
    volatile LAS unsigned* MISC;
    gu32* ctl;
    int tid, wave;
    int vcu, G;
    float* out;
    unsigned char* ws;
};
__device__ __forceinline__ float wave_sum(float v, int lane) {
#pragma unroll
    for (int o = 1; o < 64; o <<= 1) v += __builtin_bit_cast(float, __builtin_amdgcn_ds_bpermute((lane ^ o) << 2, __builtin_bit_cast(int, v)));
    return v;
}
__constant__ float ROPE_INV[32] = {1.f, 0.749894261f, 0.562341332f, 0.421696514f, 0.316227764f, 0.237137377f, 0.177827939f, 0.133352131f, 0.100000001f, 0.0749894157f, 0.0562341325f, 0.0421696529f,
    0.0316227749f, 0.0237137377f, 0.0177827943f, 0.0133352149f, 0.00999999978f, 0.00749894185f, 0.00562341325f, 0.00421696482f, 0.00316227763f, 0.00237137359f, 0.00177827943f, 0.00133352145f,
    0.00100000005f, 0.000749894243f, 0.000562341302f, 0.000421696517f, 0.000316227757f, 0.00023713737f, 0.00017782794f, 0.00013335215f};

template <int MODE> __device__ __forceinline__ int rowmap(int n) {
    if (MODE == 1) { const int bj = n >= FF ? 1 : 0, j = n - bj * FF; return (j >> 7) * 256 + bj * 128 + (j & 127); }
    if (MODE == 2) { if (n >= 2560) return n; const int h = n >> 7, d = n & 127, axis = d >> 6, nn = (d >> 5) & 1, pi = d & 31, wc = axis * 2 + (pi >> 4), fq = (pi >> 2) & 3, i = pi & 3; return h * 128 + 32 * wc + 8 * fq + 4 * nn + i; }
    return n;
}
template <int MODE>
__device__ __forceinline__ void xpose_item(const float* W, int N, bf16* WT, int ldk, int koff, LAS float* scr, int item, int lane) {
    const int nblk = N / 32, kb = item / nblk, nb = item % nblk, k0 = 64 * kb, n0 = 32 * nb;
#pragma unroll 8
    for (int i = 0; i < 32; ++i) { const int kk = 2 * i + (lane >> 5); scr[kk * 33 + (lane & 31)] = W[(size_t)(k0 + kk) * N + n0 + (lane & 31)]; }
    LDS_WAIT(); asm volatile("" ::: "memory");
    const int c = lane & 7;
#pragma unroll
    for (int j = 0; j < 4; ++j) { const int n = (lane >> 3) + 8 * j; const LAS float* s = scr + (8 * c) * 33 + n;
        v4u o; o.x = pk2(s[0 * 33], s[1 * 33]); o.y = pk2(s[2 * 33], s[3 * 33]); o.z = pk2(s[4 * 33], s[5 * 33]); o.w = pk2(s[6 * 33], s[7 * 33]);
        *(GAS v4u*)(WT + (size_t)rowmap<MODE>(n0 + n) * ldk + koff + k0 + 8 * c) = o; }
    LDS_WAIT(); asm volatile("" ::: "memory");
}
__device__ __forceinline__ void sincos_d(double a, float& c, float& s) {
    const double TWO_PI = 6.283185307179586476925, HALF_PI = 1.570796326794896619231;
    const double n = __builtin_rint(a * (1.0 / TWO_PI)); double r = a - n * TWO_PI;
    const double q = __builtin_rint(r * (1.0 / HALF_PI)); const double y = r - q * HALF_PI, y2 = y * y;
    const double sy = y * (1.0 - y2 / 6.0 * (1.0 - y2 / 20.0 * (1.0 - y2 / 42.0 * (1.0 - y2 / 72.0 * (1.0 - y2 / 110.0 * (1.0 - y2 / 156.0 * (1.0 - y2 / 210.0)))))));
    const double cy = 1.0 - y2 / 2.0 * (1.0 - y2 / 12.0 * (1.0 - y2 / 30.0 * (1.0 - y2 / 56.0 * (1.0 - y2 / 90.0 * (1.0 - y2 / 132.0 * (1.0 - y2 / 182.0))))));
    const int qi = ((int)q) & 3;
    const double cc = (qi == 0) ? cy : (qi == 1) ? -sy : (qi == 2) ? -cy : sy;
    const double ss = (qi == 0) ? sy : (qi == 1) ? cy : (qi == 2) ? -sy : -cy;
    c = (float)cc; s = (float)ss;
}

struct CvtJob { const float* src; bf16* dst; int N, ldk, koff, mode, nitems; };
__device__ __forceinline__ CvtJob cvt_job(const Args& A, unsigned char* ws, int jg) {
    const int l = jg >> 3, j = jg & 7; unsigned char* wl = ws + WS_W + (size_t)l * W_LAYER; CvtJob J;
    switch (j) {
    case 0: J = CvtJob{A.in[7] + (size_t)l * D * 2 * FF, (bf16*)(wl + W_WI1), 2 * FF, D, 0, 1, (D / 64) * (2 * FF / 32)}; break;
    case 1: J = CvtJob{A.in[8] + (size_t)l * FF * D, (bf16*)(wl + W_WO1), D, FF, 0, 0, (FF / 64) * (D / 32)}; break;
    case 2: J = CvtJob{A.in[9] + (size_t)l * D * NIN, (bf16*)(wl + W_WIN), NIN, D, 0, 2, (D / 64) * (NIN / 32)}; break;
    case 3: J = CvtJob{A.in[14] + (size_t)l * D * D, (bf16*)(wl + W_WMRG), D, KCAT, 0, 0, (D / 64) * (D / 32)}; break;
    case 4: J = CvtJob{A.in[16] + (size_t)l * 1024 * D, (bf16*)(wl + W_WMRG), D, KCAT, 3072, 0, (1024 / 64) * (D / 32)}; break;
    case 5: J = CvtJob{A.in[17] + (size_t)l * D * D, (bf16*)(wl + W_WOUT), D, D, 0, 0, (D / 64) * (D / 32)}; break;
    case 6: J = CvtJob{A.in[18] + (size_t)l * D * 2 * FF, (bf16*)(wl + W_WI2), 2 * FF, D, 0, 1, (D / 64) * (2 * FF / 32)}; break;
    default: J = CvtJob{A.in[19] + (size_t)l * FF * D, (bf16*)(wl + W_WO2), D, FF, 0, 0, (FF / 64) * (D / 32)}; break;
    }
    return J;
}
__device__ __forceinline__ int rowmap_rt(int mode, int n) { return mode == 1 ? rowmap<1>(n) : (mode == 2 ? rowmap<2>(n) : n); }
struct CvtItem { const float* src; bf16* dst; int N, ldk, mode; bool ok; };
__device__ __forceinline__ CvtItem cvt_decode(const Args& A, unsigned char* ws, int j0, int j1, int it) {
    CvtItem I; I.ok = false; I.src = nullptr; I.dst = nullptr; I.N = 0; I.ldk = 0; I.mode = 0;
    for (int jg = j0; jg < j1; ++jg) { const CvtJob J = cvt_job(A, ws, jg);
        if (it < J.nitems) { const int nblk = J.N >> 5, kb = it / nblk, nb = it - kb * nblk; I.src = J.src + (size_t)(64 * kb) * J.N + 32 * nb; I.dst = J.dst + J.koff + 64 * kb; I.N = J.N; I.ldk = J.ldk; I.mode = J.mode | ((32 * nb) << 2); I.ok = true; break; }
        it -= J.nitems; }
    return I;
}
__device__ __forceinline__ void cvt_load(const CvtItem& I, f32x4 (&v)[8], int lane) {
    const float* p = I.src + (size_t)(lane >> 3) * I.N + 4 * (lane & 7);
#pragma unroll
    for (int i = 0; i < 8; ++i) v[i] = *(const GAS f32x4*)(p + (size_t)(8 * i) * I.N);
}
__device__ __forceinline__ void cvt_store(const CvtItem& I, const f32x4 (&v)[8], LAS float* scr, int lane) {
    const int kk0 = lane >> 3, n4 = 4 * (lane & 7);
#pragma unroll
    for (int i = 0; i < 8; ++i) { LAS float* s = scr + (kk0 + 8 * i) * 33 + n4; s[0] = v[i].x; s[1] = v[i].y; s[2] = v[i].z; s[3] = v[i].w; }
    LDS_WAIT(); asm volatile("" ::: "memory");
    const int c = lane & 7, n0 = I.mode >> 2, mode = I.mode & 3;
#pragma unroll
    for (int j = 0; j < 4; ++j) { const int n = (lane >> 3) + 8 * j; const LAS float* s = scr + (8 * c) * 33 + n;
        v4u o; o.x = pk2(s[0 * 33], s[1 * 33]); o.y = pk2(s[2 * 33], s[3 * 33]); o.z = pk2(s[4 * 33], s[5 * 33]); o.w = pk2(s[6 * 33], s[7 * 33]);
        *(GAS v4u*)(I.dst + (size_t)rowmap_rt(mode, n0 + n) * I.ldk + 8 * c) = o; }
    LDS_WAIT(); asm volatile("" ::: "memory");
}
__device__ __forceinline__ void convert_jobs(Frame& F, const Args& A, int j0, int j1, gu32* qword) {
    int total = 0; for (int jg = j0; jg < j1; ++jg) total += cvt_job(A, F.ws, jg).nitems;
    LAS float* scr = (LAS float*)(F.lds + F.wave * 8704);
    const int lane = F.tid & 63;
    int base = 0, left = 0;
    auto grab = [&]() { unsigned b = 0; if (lane == 0) b = __hip_atomic_fetch_add(qword, 4u, RLX_AGENT); base = __builtin_amdgcn_readfirstlane((int)b); left = 4; };
    grab();
    f32x4 va[8], vb[8];
    CvtItem cur = cvt_decode(A, F.ws, j0, j1, base < total ? base : 0); cur.ok = cur.ok && (base < total);
    if (cur.ok) cvt_load(cur, va, lane);
    while (cur.ok) {
        ++base; --left; if (left == 0) grab();
        CvtItem nxt = cvt_decode(A, F.ws, j0, j1, base < total ? base : 0); nxt.ok = nxt.ok && (base < total);
        if (nxt.ok) cvt_load(nxt, vb, lane);
        cvt_store(cur, va, scr, lane);
        cur = nxt;
#pragma unroll
        for (int i = 0; i < 8; ++i) va[i] = vb[i];
    }
}
__device__ __forceinline__ void p0_prologue(Frame& F, const Args& A) {
    const int gw = F.vcu * NWAVES + F.wave, NGW = F.G * NWAVES;
    const int gtid = F.vcu * 512 + F.tid, NGT = F.G * 512;
    {
        LAS float* sil = (LAS float*)(F.lds + 69632);
        LAS float* red = (LAS float*)(F.lds + 86016);
        const float* c = A.in[1]; const float* cc = A.in[3]; const float* w_ada = A.in[4]; const float* b_ada = A.in[5];
        float* mods = (float*)(F.ws + WS_MODS);
        for (int i = F.tid; i < 2048; i += 512) { sil[i] = siluf_(c[i]); sil[2048 + i] = siluf_(cc[i]); }
        __syncthreads();
        for (int it = F.vcu; it < 2 * 72; it += F.G) {
            const int l = it / 72, nb = it % 72, n0 = nb * 256 + 4 * (F.tid & 63);
            f32x4 a0 = {0.f, 0.f, 0.f, 0.f}, a1 = {0.f, 0.f, 0.f, 0.f};
            const float* wp = w_ada + (size_t)l * 2048 * 18432 + n0;
#pragma unroll 8
            for (int k = F.wave; k < 2048; k += 8) { const f32x4 wv = *(const GAS f32x4*)(wp + (size_t)k * 18432); const float s0 = sil[k], s1 = sil[2048 + k]; a0 += wv * s0; a1 += wv * s1; }
            *(LAS f32x4*)(red + (F.wave * 2 + 0) * 256 + 4 * (F.tid & 63)) = a0; *(LAS f32x4*)(red + (F.wave * 2 + 1) * 256 + 4 * (F.tid & 63)) = a1;
            __syncthreads();
            { const int v = F.tid >> 8, col = F.tid & 255; float s = 0.f;
#pragma unroll
              for (int w = 0; w < 8; ++w) s += red[(w * 2 + v) * 256 + col];
              mods[(size_t)(l * 2 + v) * 18432 + nb * 256 + col] = s + b_ada[l * 18432 + nb * 256 + col]; }
            __syncthreads();
        }
    }
    { f32x2* tab = (f32x2*)(F.ws + WS_ROPE);
      for (int i = gtid; i < 128 * 32; i += NGT) { const int pos = i >> 5, pi = i & 31; const float ang = (float)pos * ROPE_INV[pi]; float c, s; sincos_d((double)ang, c, s); tab[i] = (f32x2){c, s}; } }
    { const GAS f32x4* x4 = (const GAS f32x4*)A.in[0]; const GAS f32x4* c4 = (const GAS f32x4*)A.in[2]; GAS f32x4* h4 = (GAS f32x4*)(F.ws + WS_H);
      for (int i = gtid; i < L * D / 4; i += NGT) h4[i] = x4[i];
      for (int i = gtid; i < LC * D / 4; i += NGT) h4[L * D / 4 + i] = c4[i]; }
    for (int it = gw; it < 2 * 4 * 32 * 32; it += NGW) {
        const int dblk = it & 31, c8 = (it >> 5) & 31, g = (it >> 10) & 3, l = it >> 12;
        const int d = dblk * 64 + (F.tid & 63);
        const float* pw = A.in[11] + ((size_t)(l * 4 + g) * 256 + c8 * 8) * 256;
        const float* sc = A.in[12] + l * 1024 + g * 256;
        const float* wpo = A.in[15] + ((size_t)l * 1024 + g * 256) * 2048 + d;
        float acc[8];
#pragma unroll
        for (int i = 0; i < 8; ++i) acc[i] = 0.f;
#pragma unroll 4
        for (int j = 0; j < 256; ++j) { const float t = sc[j] * wpo[(size_t)j * 2048];
#pragma unroll
            for (int i = 0; i < 8; ++i) acc[i] += pw[i * 256 + j] * t; }
        bf16* wt = (bf16*)(F.ws + WS_W + (size_t)l * W_LAYER + W_WMRG);
        v4u o; o.x = pk2(acc[0], acc[1]); o.y = pk2(acc[2], acc[3]); o.z = pk2(acc[4], acc[5]); o.w = pk2(acc[6], acc[7]);
        *(GAS v4u*)(wt + (size_t)d * KCAT + 2048 + g * 256 + c8 * 8) = o;
    }
    __syncthreads();
    convert_jobs(F, A, 0, 1, F.ctl + CW_Q + 0 * 64);
}

template <bool FINAL>
__device__ __forceinline__ void norm_phase(Frame& F, int l, const float* gnorm, int shift_idx, int scale_idx) {
    LAS float* TA = (LAS float*)(F.lds);
    LAS float* TB = TA + 4096;
    const float* mods = (const float*)(F.ws + WS_MODS);
    for (int i = F.tid; i < 4096; i += 512) { const int v = i >> 11, col = i & 2047; const float* mv = mods + (size_t)(l * 2 + v) * 18432;
        if (FINAL) { TA[i] = gnorm[col]; TB[i] = 0.f; } else { TA[i] = gnorm[col] * (1.0f + mv[scale_idx * 2048 + col]); TB[i] = mv[shift_idx * 2048 + col]; } }
    __syncthreads();
    const int gw = F.vcu * NWAVES + F.wave, NGW = F.G * NWAVES;
    const float* H = (const float*)(F.ws + WS_H); bf16* XN = (bf16*)(F.ws + WS_XN);
    const int nrows = FINAL ? L : MALL;
    for (int r = gw; r < nrows; r += NGW) {
        const int v = (r >= L) ? 1 : 0;
        const GAS f32x4* hr = (const GAS f32x4*)(H + (size_t)r * D) + (F.tid & 63);
        f32x4 x[8];
#pragma unroll
        for (int j = 0; j < 8; ++j) x[j] = hr[64 * j];
        float ss = 0.f;
#pragma unroll
        for (int j = 0; j < 8; ++j) ss += (x[j].x * x[j].x + x[j].y * x[j].y) + (x[j].z * x[j].z + x[j].w * x[j].w);
        const float rstd = 1.0f / sqrtf(wave_sum(ss, (F.tid & 63)) * (1.0f / D) + EPS);
        if (FINAL) { GAS f32x4* o = (GAS f32x4*)(F.out + (size_t)r * D) + (F.tid & 63);
#pragma unroll
            for (int j = 0; j < 8; ++j) { const f32x4 av = *(LAS f32x4*)(TA + 4 * (F.tid & 63) + 256 * j); o[64 * j] = x[j] * rstd * av; } }
        else { GAS v2u* o = (GAS v2u*)(XN + (size_t)r * D) + (F.tid & 63);
#pragma unroll
            for (int j = 0; j < 8; ++j) { const f32x4 av = *(LAS f32x4*)(TA + v * 2048 + 4 * (F.tid & 63) + 256 * j), bv = *(LAS f32x4*)(TB + v * 2048 + 4 * (F.tid & 63) + 256 * j);
                const f32x4 y = x[j] * rstd * av + bv; v2u w; w.x = pk2(y.x, y.y); w.y = pk2(y.z, y.w); o[64 * j] = w; } }
    }
    __syncthreads();
}

__device__ __forceinline__ void prep_phase(Frame& F, const float* conv_w) {
    const bf16* P = (const bf16*)(F.ws + WS_P); bf16* ACAT = (bf16*)(F.ws + WS_ACAT);
    const int gtid = F.vcu * 512 + F.tid, NGT = F.G * 512;
    for (int i = gtid; i < MALL * 128; i += NGT) { const int r = i >> 7, c = (i & 127) * 8, g = c >> 8, w = 2 << g;
        const int s0 = (r >= L) ? L : 0, sl = (r >= L) ? LC : L, tt0 = r - s0;
        int lo = tt0 - (w >> 1); lo = lo < 0 ? 0 : lo; int hi = tt0 + (w - (w >> 1)) - 1; hi = hi > sl - 1 ? sl - 1 : hi;
        float acc[8];
#pragma unroll
        for (int k = 0; k < 8; ++k) acc[k] = 0.f;
        for (int tt = lo; tt <= hi; ++tt) { const v4u u = *(const GAS v4u*)(P + (size_t)(s0 + tt) * NIN + POOL_OFF + c);
#pragma unroll
            for (int k = 0; k < 4; ++k) { acc[2 * k] += bflo(u[k]); acc[2 * k + 1] += bfhi(u[k]); } }
        const float inv = 1.0f / (float)(hi - lo + 1); const v4u u = *(const GAS v4u*)(P + (size_t)r * NIN + POOL_OFF + c); v4u o;
#pragma unroll
        for (int k = 0; k < 4; ++k) o[k] = pk2(acc[2 * k] * inv - bflo(u[k]), acc[2 * k + 1] * inv - bfhi(u[k]));
        *(GAS v4u*)(ACAT + (size_t)r * KCAT + 2048 + c) = o; }
    const float* cw = conv_w;
    for (int i = gtid; i < MALL * 128; i += NGT) { const int r = i >> 7, c = (i & 127) * 8;
        const int s0 = (r >= L) ? L : 0, sl = (r >= L) ? LC : L, tt0 = r - s0;
        float cx[3][8];
#pragma unroll
        for (int dt = 0; dt < 3; ++dt) { const int tt = tt0 + dt - 1;
            if (tt >= 0 && tt < sl) { const bf16* pr = P + (size_t)(s0 + tt) * NIN; const v4u cg = *(const GAS v4u*)(pr + CC_OFF + c), xv = *(const GAS v4u*)(pr + CX_OFF + c);
#pragma unroll
                for (int k = 0; k < 4; ++k) { cx[dt][2 * k] = bflo(cg[k]) * bflo(xv[k]); cx[dt][2 * k + 1] = bfhi(cg[k]) * bfhi(xv[k]); } }
            else {
#pragma unroll
                for (int k = 0; k < 8; ++k) cx[dt][k] = 0.f; } }
        const v4u bg = *(const GAS v4u*)(P + (size_t)r * NIN + CB_OFF + c); float y[8];
#pragma unroll
        for (int k = 0; k < 8; ++k) y[k] = cx[0][k] * cw[c + k] + cx[1][k] * cw[1024 + c + k] + cx[2][k] * cw[2048 + c + k];
        v4u o;
#pragma unroll
        for (int k = 0; k < 4; ++k) o[k] = pk2(bflo(bg[k]) * y[2 * k], bfhi(bg[k]) * y[2 * k + 1]);
        *(GAS v4u*)(ACAT + (size_t)r * KCAT + 3072 + c) = o; }
}

typedef short s16x8 __attribute__((ext_vector_type(8)));
typedef float f32x16 __attribute__((ext_vector_type(16)));
__device__ __forceinline__ f32x4 mini_tile(const bf16* A, int lda, const bf16* Bt, int ldb, int k0, int klen, int r0, int c0, LAS float* red, int tid) {
    const int wave = __builtin_amdgcn_readfirstlane(tid >> 6), lane = tid & 63, r32 = lane & 31, hi = lane >> 5;
    const int kw = klen >> 3, kb = k0 + wave * kw;
    const bf16* ap = A + (size_t)(r0 + r32) * lda + kb + 8 * hi; const bf16* b0p = Bt + (size_t)(c0 + r32) * ldb + kb + 8 * hi; const bf16* b1p = b0p + (size_t)32 * ldb;
    f32x16 acc0 = {}, acc1 = {};
#pragma unroll 4
    for (int k = 0; k < kw; k += 16) { const s16x8 a = *(const GAS s16x8*)(ap + k), b0 = *(const GAS s16x8*)(b0p + k), b1 = *(const GAS s16x8*)(b1p + k);
        acc0 = __builtin_amdgcn_mfma_f32_32x32x16_bf16(a, b0, acc0, 0, 0, 0); acc1 = __builtin_amdgcn_mfma_f32_32x32x16_bf16(a, b1, acc1, 0, 0, 0); }
#pragma unroll
    for (int r = 0; r < 16; ++r) { const int row = (r & 3) + 8 * (r >> 2) + 4 * hi; red[(wave * 32 + row) * 64 + r32] = acc0[r]; red[(wave * 32 + row) * 64 + 32 + r32] = acc1[r]; }
    __syncthreads();
    const int row = tid >> 4, c4 = (tid & 15) * 4; f32x4 s = {0.f, 0.f, 0.f, 0.f};
#pragma unroll
    for (int w = 0; w < 8; ++w) s += *(LAS f32x4*)(red + (w * 32 + row) * 64 + c4);
    __syncthreads();
    return s;
}
__device__ __forceinline__ void ctx_resid(Frame& F, const bf16* A, int lda, const bf16* Bt, int K, const float* gate, float gs) {
    float* H = (float*)(F.ws + WS_H);
    for (int mt = F.vcu; mt < 256; mt += F.G) { const int r0 = (mt >> 5) * 32, c0 = (mt & 31) * 64;
        const f32x4 v = mini_tile(A + (size_t)L * lda, lda, Bt, K, 0, K, r0, c0, (LAS float*)F.lds, F.tid);
        const int row = L + r0 + (F.tid >> 4), col = c0 + 4 * (F.tid & 15);
        f32x4* p = (f32x4*)(H + (size_t)row * D + col); *p = *p + *(const f32x4*)(gate + col) * gs * v; }
}
__device__ __forceinline__ void ctx_merge(Frame& F, const bf16* Bt) {
    const bf16* ACAT = (const bf16*)(F.ws + WS_ACAT); const bf16* P = (const bf16*)(F.ws + WS_P); bf16* MRG = (bf16*)(F.ws + WS_MRG);
    for (int mt = F.vcu; mt < 256; mt += F.G) { const int r0 = (mt >> 5) * 32, c0 = (mt & 31) * 64;
        const int row = L + r0 + (F.tid >> 4), col = c0 + 4 * (F.tid & 15); f32x4 s = {0.f, 0.f, 0.f, 0.f};
#pragma unroll
        for (int sg = 0; sg < 3; ++sg) { const int k0 = sg == 0 ? 0 : (sg == 1 ? 2048 : 3072), kl = sg == 0 ? 2048 : 1024;
            const f32x4 v = mini_tile(ACAT + (size_t)L * KCAT, KCAT, Bt, KCAT, k0, kl, r0, c0, (LAS float*)F.lds, F.tid);
            const v2u gw = *(const GAS v2u*)(P + (size_t)row * NIN + GATE_OFF + sg * D + col);
            s[0] += bflo(gw.x) * v[0]; s[1] += bfhi(gw.x) * v[1]; s[2] += bflo(gw.y) * v[2]; s[3] += bfhi(gw.y) * v[3]; }
        v2u w; w.x = pk2(s[0], s[1]); w.y = pk2(s[2], s[3]); *(GAS v2u*)(MRG + (size_t)row * D + col) = w; }
}

__device__ __forceinline__ void attn_phase(Frame& F, const float* sink, int nunits, char* lds) {
    const bf16* P = (const bf16*)(F.ws + WS_P); bf16* ACAT = (bf16*)(F.ws + WS_ACAT);
    for (int u = F.vcu; u < nunits; u += F.G) { const int hp = u & 1, kvh = (u >> 1) & 3, qb = u >> 3;
        att::attn_unit(P, NIN, Q_OFF, K_OFF, V_OFF, ACAT, KCAT, qb, kvh, kvh * 4 + hp * 2, sink, lds, F.tid); }
    __syncthreads();
}

__global__ void __launch_bounds__(NWAVES * 64, 2) fwd(Args args) {
    extern __shared__ __attribute__((aligned(16))) unsigned char lds[];
    Frame F;
    F.lds = (LAS unsigned char*)lds;
    F.MISC = (volatile LAS unsigned*)(F.lds + MISC_OFF);
    F.tid = threadIdx.x; F.wave = __builtin_amdgcn_readfirstlane(F.tid >> 6);
    F.G = gridDim.x; { const int bx = blockIdx.x; F.vcu = (F.G % 8 == 0) ? (bx % 8) * (F.G / 8) + bx / 8 : bx; }
    F.ws = args.ws; F.out = args.out; F.ctl = (gu32*)(args.ws + WS_CTL);
    for (int u = F.tid; u < (LDS_BYTES - LDSCTL_OFF) / 4; u += NWAVES * 64) ((LAS unsigned*)(F.lds + LDSCTL_OFF))[u] = 0u;
    __syncthreads();
    const int lo = args.ph_lo, hi = args.ph_hi;
    XcdBarrier bar; bar.bar = (unsigned*)(F.ctl + CW_BAR); bar.x = 0; bar.st = nullptr;
    if (hi - lo > 1) bar = xcd_barrier_post((unsigned*)(F.ctl + CW_BAR), F.MISC + 8, F.tid);
#define IN(k) (lo <= (k) && (k) < hi)
#define SEAM(k) do { if (IN(k) && IN((k) + 1)) xcd_barrier(bar, F.tid); } while (0)
    int bx = blockIdx.x;
#define LAUNDER() do { asm volatile("" : "+v"(F.tid)); asm volatile("" : "+s"(F.wave), "+s"(F.vcu), "+s"(F.G), "+s"(bx)); } while (0)
    bf16* XN = (bf16*)(F.ws + WS_XN); bf16* ACT = (bf16*)(F.ws + WS_ACT); bf16* P = (bf16*)(F.ws + WS_P); bf16* ACAT = (bf16*)(F.ws + WS_ACAT);
    bf16* MRG = (bf16*)(F.ws + WS_MRG); float* C = (float*)(F.ws + WS_C); float* Hs = (float*)(F.ws + WS_H);

    LAUNDER(); if (IN(0)) { p0_prologue(F, args); } SEAM(0);

    for (int l = 0; l < NLAYER; ++l) {
        const int pb = 1 + l * NPL; const bool lastl = (l == NLAYER - 1);
        unsigned char* wl = F.ws + WS_W + (size_t)l * W_LAYER;
        const float* ng = args.in[6] + (size_t)l * 3 * D;
        const float* mlat = (const float*)(F.ws + WS_MODS) + (size_t)(l * 2 + 0) * 18432; const float* mctx = mlat + 18432;
        LAUNDER(); if (IN(pb + 0)) norm_phase<false>(F, l, ng, 0, 1);
        SEAM(pb + 0);
        LAUNDER(); if (IN(pb + 1)) { pg8::Gemm g{XN, (const bf16*)(wl + W_WI1), D}; pg8::StaticOrder S; S.init(MALL, 2 * FF, D, F.G, bx); pg8::EpiSwiglu E{ACT, FF};
            pg8::gemm_phase<pg8::EpiSwiglu, pg8::StaticOrder, true, true>(F.lds + RING_OFF, g, S, E, F.tid);
            convert_jobs(F, args, 8 * l + 1, 8 * l + 3, F.ctl + CW_Q + (1 + 3 * l) * 64); }
        SEAM(pb + 1);
        LAUNDER(); if (IN(pb + 2)) { pg8::Gemm g{ACT, (const bf16*)(wl + W_WO1), FF}; pg8::StaticOrder S; S.init(L, D, FF, F.G, bx); pg8::EpiResid E{Hs, D, mlat + 2 * D, 0.5f};
            pg8::gemm_phase<pg8::EpiResid, pg8::StaticOrder, true, true>(F.lds + RING_OFF, g, S, E, F.tid);
            ctx_resid(F, ACT, FF, (const bf16*)(wl + W_WO1), FF, mctx + 2 * D, 0.5f); }
        SEAM(pb + 2);
        LAUNDER(); if (IN(pb + 3)) norm_phase<false>(F, l, ng + D, 3, 4);
        SEAM(pb + 3);
        LAUNDER(); if (IN(pb + 4)) { pg8::Gemm g{XN, (const bf16*)(wl + W_WIN), D}; pg8::StaticOrder S; S.init(MALL, NIN, D, F.G, bx); pg8::EpiIn E{P, NIN, (const float*)(F.ws + WS_ROPE), L, 10, 28};
            pg8::gemm_phase<pg8::EpiIn, pg8::StaticOrder, true, true>(F.lds + RING_OFF, g, S, E, F.tid);
            convert_jobs(F, args, 8 * l + 3, 8 * l + 7, F.ctl + CW_Q + (2 + 3 * l) * 64); }
        SEAM(pb + 4);
        LAUNDER(); if (IN(pb + 5)) { attn_phase(F, args.in[10] + l * NQH, lastl ? 512 : 528, (char*)lds + RING_OFF); prep_phase(F, args.in[13] + (size_t)l * 3 * 1024); }
        SEAM(pb + 5);
        LAUNDER(); if (IN(pb + 6)) { pg8::Gemm g{ACAT, (const bf16*)(wl + W_WMRG), KCAT}; pg8::SegOrder S; S.init(L, D, KCAT, F.G, bx); pg8::EpiMerge E{P, NIN, GATE_OFF, C, MRG, D};
            pg8::gemm_phase<pg8::EpiMerge, pg8::SegOrder, true, true>(F.lds + RING_OFF, g, S, E, F.tid);
            if (!lastl) ctx_merge(F, (const bf16*)(wl + W_WMRG)); }
        SEAM(pb + 6);
        LAUNDER(); if (IN(pb + 7)) { pg8::Gemm g{MRG, (const bf16*)(wl + W_WOUT), D}; pg8::StaticOrder S; S.init(L, D, D, F.G, bx); pg8::EpiResid E{Hs, D, mlat + 5 * D, 1.0f};
            pg8::gemm_phase<pg8::EpiResid, pg8::StaticOrder, true, true>(F.lds + RING_OFF, g, S, E, F.tid);
            if (!lastl) ctx_resid(F, MRG, D, (const bf16*)(wl + W_WOUT), D, mctx + 5 * D, 1.0f); }
        SEAM(pb + 7);
        LAUNDER(); if (IN(pb + 8)) norm_phase<false>(F, l, ng + 2 * D, 6, 7);
        SEAM(pb + 8);
        LAUNDER(); if (IN(pb + 9)) { pg8::Gemm g{XN, (const bf16*)(wl + W_WI2), D}; pg8::StaticOrder S; S.init(MALL, 2 * FF, D, F.G, bx); pg8::EpiSwiglu E{ACT, FF};
            pg8::gemm_phase<pg8::EpiSwiglu, pg8::StaticOrder, true, true>(F.lds + RING_OFF, g, S, E, F.tid);
            convert_jobs(F, args, 8 * l + 7, (8 * l + 9 < 16) ? 8 * l + 9 : 16, F.ctl + CW_Q + (3 + 3 * l) * 64); }
        SEAM(pb + 9);
        LAUNDER(); if (IN(pb + 10)) { pg8::Gemm g{ACT, (const bf16*)(wl + W_WO2), FF}; pg8::StaticOrder S; S.init(L, D, FF, F.G, bx); pg8::EpiResid E{Hs, D, mlat + 8 * D, 0.5f};
            pg8::gemm_phase<pg8::EpiResid, pg8::StaticOrder, true, true>(F.lds + RING_OFF, g, S, E, F.tid);
            if (!lastl) ctx_resid(F, ACT, FF, (const bf16*)(wl + W_WO2), FF, mctx + 8 * D, 0.5f); }
        SEAM(pb + 10);
    }
    LAUNDER(); if (IN(NPHASE - 1)) norm_phase<true>(F, NLAYER - 1, args.in[20], 0, 0);
#undef IN
#undef SEAM
#undef LAUNDER
}

extern "C" void kernel_launch(void* const* d_in, const int* in_sizes, int n_in, void* d_out, int out_size, void* d_ws, size_t ws_size, hipStream_t stream) {
    static int grid = 0;
    if (grid == 0) {
        if (n_in != 21 || in_sizes[0] != L * D || out_size != L * D || ws_size < WS_END) { fprintf(stderr, "kernel_launch: shape mismatch n_in %d in0 %d out %d ws %zu (need %zu)\n", n_in, n_in > 0 ? in_sizes[0] : -1, out_size, ws_size, (size_t)WS_END); grid = -1; return; }
        int dev = 0, cus = 0, per_cu = 0;
        if (hipGetDevice(&dev) != hipSuccess || hipDeviceGetAttribute(&cus, hipDeviceAttributeMultiprocessorCount, dev) != hipSuccess) { grid = -1; return; }
        if (hipFuncSetAttribute((const void*)fwd, hipFuncAttributeMaxDynamicSharedMemorySize, LDS_BYTES) != hipSuccess) { fprintf(stderr, "kernel_launch: hipFuncSetAttribute failed\n"); grid = -1; return; }
        if (hipOccupancyMaxActiveBlocksPerMultiprocessor(&per_cu, (const void*)fwd, NWAVES * 64, LDS_BYTES) != hipSuccess || per_cu < 1) fprintf(stderr, "kernel_launch: occupancy query says %d\n", per_cu);
        (void)hipGetLastError();
        grid = cus;
    }
    if (grid < 0) return;
    (void)hipMemsetAsync((char*)d_ws + WS_CTL, 0, CTL_ZERO_BYTES, stream);
    Args a{};
    for (int i = 0; i < 21; ++i) a.in[i] = (const float*)d_in[i];
    a.out = (float*)d_out; a.ws = (unsigned char*)d_ws;
#if defined(MK_PER_PHASE)
    for (int ph = 0; ph < NPHASE; ++ph) { a.ph_lo = ph; a.ph_hi = ph + 1; hipLaunchKernelGGL(fwd, dim3(grid), dim3(NWAVES * 64), LDS_BYTES, stream, a); }
#else
    a.ph_lo = 0; a.ph_hi = NPHASE; hipLaunchKernelGGL(fwd, dim3(grid), dim3(NWAVES * 64), LDS_BYTES, stream, a);
#endif
    const hipError_t le = hipPeekAtLastError();
    if (le != hipSuccess) fprintf(stderr, "kernel_launch: launch failed: %s\n", hipGetErrorName(le));
}
```

```cpp
#include <hip/hip_runtime.h>
#include <cstdio>
#include <cstdint>
namespace pg8 {
#define PG8_LAS __attribute__((address_space(3)))
typedef unsigned short bf16_t;
typedef short bf16x8 __attribute__((ext_vector_type(8)));
typedef float f32x4 __attribute__((ext_vector_type(4)));
typedef unsigned u32x4 __attribute__((ext_vector_type(4)));
constexpr int BM = 256, BK = 64, HALF = 128, HTB = HALF * BK * 2  , STAGE_BYTES = 8 * HTB, NXCD = 8, WGM = 8;

__host__ __device__ __forceinline__ int lds_byte(int r, int c) { const int st = (r >> 4) * 2 + (c >> 5), rr = r & 15, cc = c & 31, ob = rr * 64 + cc * 2; return st * 1024 + (ob ^ (((ob >> 9) & 1) << 5)); }
__host__ __device__ __forceinline__ void stage_rc(int b, int& R, int& C) { const int st = b / 1024, sb = b % 1024, swz = sb ^ (((sb >> 9) & 1) << 5); R = (st >> 1) * 16 + swz / 64; C = (st & 1) * 32 + (swz % 64) / 2; }
__host__ __device__ __forceinline__ int perm32(int rho) { const int n = rho >> 4, i = rho & 15; return 8 * (i >> 2) + 4 * n + (i & 3); }

struct Unit { int pm, pn, seg; };
struct Gemm { const bf16_t* A; const bf16_t* Bt; int K; };

struct StaticOrder {
    int nM, nN, nwg, G, c, ntk;
    __host__ __device__ void init(int M, int N, int K, int G_, int c_) { nM = M / BM; nN = N / BM; nwg = nM * nN; G = G_; c = c_; ntk = K / BK; }
    __device__ __forceinline__ int koff(const Unit&) const { return 0; }
    __device__ __forceinline__ int nt(const Unit&) const { return ntk; }
    __host__ __device__ bool next(int i, Unit& u) const {
        const long L = (long)i * G + c; if (L >= nwg) return false;
        int wgid = (int)L; { const int q = nwg / NXCD, r = nwg % NXCD, xcd = wgid % NXCD, off = wgid / NXCD; wgid = (xcd < r ? xcd * (q + 1) : r * (q + 1) + (xcd - r) * q) + off; }
        const int nig = WGM * nN, gid = wgid / nig, fm = gid * WGM, gsz = (nM - fm) < WGM ? (nM - fm) : WGM;
        u.pm = fm + ((wgid % nig) % gsz); u.pn = (wgid % nig) / gsz; u.seg = 0; return true;
    }
    __device__ __forceinline__ void a_ready(const Unit&) const {}
    __device__ __forceinline__ void done(const Unit&) const {}
};


__device__ __forceinline__ unsigned cvt_pk_bf16(float lo, float hi) { unsigned r; asm volatile("v_cvt_pk_bf16_f32 %0, %1, %2" : "=v"(r) : "v"(lo), "v"(hi)); return r; }

struct EpiF32 {
    static constexpr bool PERM = false, AFTER_DRAIN = false;
    float* C; int ldc;
    __device__ __forceinline__ void operator()(const f32x4 (&acc)[2][2][4][2], const Unit& u, int wr, int wc, int fr, int fq) const {
        const int row0 = u.pm * BM + wr * 64 + fr, col0 = u.pn * BM + wc * 32 + 4 * fq;
#pragma unroll
        for (int ai = 0; ai < 2; ++ai)
#pragma unroll
            for (int m = 0; m < 4; ++m) { float* rowp = C + (size_t)(row0 + ai * HALF + m * 16) * ldc + col0;
#pragma unroll
                for (int bj = 0; bj < 2; ++bj)
#pragma unroll
                    for (int n = 0; n < 2; ++n) *(f32x4*)(rowp + bj * HALF + n * 16) = acc[ai][bj][m][n]; }
    }
};
struct EpiBf16 {
    static constexpr bool PERM = true, AFTER_DRAIN = false;
    bf16_t* O; int ldc; size_t seg_stride;
    __device__ __forceinline__ void operator()(const f32x4 (&acc)[2][2][4][2], const Unit& u, int wr, int wc, int fr, int fq) const {
        const int row0 = u.pm * BM + wr * 64 + fr, col0 = u.pn * BM + wc * 32 + 8 * fq; bf16_t* base = O + (size_t)u.seg * seg_stride;
#pragma unroll
        for (int ai = 0; ai < 2; ++ai)
#pragma unroll
            for (int m = 0; m < 4; ++m) { bf16_t* rowp = base + (size_t)(row0 + ai * HALF + m * 16) * ldc + col0;
#pragma unroll
                for (int bj = 0; bj < 2; ++bj) { const f32x4 v0 = acc[ai][bj][m][0], v1 = acc[ai][bj][m][1];
                    u32x4 w; w.x = cvt_pk_bf16(v0[0], v0[1]); w.y = cvt_pk_bf16(v0[2], v0[3]); w.z = cvt_pk_bf16(v1[0], v1[1]); w.w = cvt_pk_bf16(v1[2], v1[3]);
                    *(u32x4*)(rowp + bj * HALF) = w; } }
    }
};

__device__ __forceinline__ float fast_sigmoid(float x) { return __builtin_amdgcn_rcpf(1.0f + __builtin_amdgcn_exp2f(-1.4426950408889634f * x)); }
struct EpiSwiglu {
    static constexpr bool PERM = true, AFTER_DRAIN = false;
    bf16_t* O; int ldc;
    __device__ __forceinline__ void operator()(const f32x4 (&acc)[2][2][4][2], const Unit& u, int wr, int wc, int fr, int fq) const {
        const int row0 = u.pm * BM + wr * 64 + fr, col0 = u.pn * HALF + wc * 32 + 8 * fq;
#pragma unroll
        for (int ai = 0; ai < 2; ++ai)
#pragma unroll
            for (int m = 0; m < 4; ++m) { bf16_t* rowp = O + (size_t)(row0 + ai * HALF + m * 16) * ldc + col0; f32x4 y[2];
#pragma unroll
                for (int n = 0; n < 2; ++n) { const f32x4 g = acc[ai][0][m][n], uu = acc[ai][1][m][n];
#pragma unroll
                    for (int i = 0; i < 4; ++i) y[n][i] = g[i] * fast_sigmoid(g[i]) * uu[i]; }
                u32x4 w; w.x = cvt_pk_bf16(y[0][0], y[0][1]); w.y = cvt_pk_bf16(y[0][2], y[0][3]); w.z = cvt_pk_bf16(y[1][0], y[1][1]); w.w = cvt_pk_bf16(y[1][2], y[1][3]);
                *(u32x4*)rowp = w; }
    }
};
struct EpiResid {
    static constexpr bool PERM = false, AFTER_DRAIN = false;
    float* H; int ldc; const float* gate; float gs;
    __device__ __forceinline__ void operator()(const f32x4 (&acc)[2][2][4][2], const Unit& u, int wr, int wc, int fr, int fq) const {
        const int row0 = u.pm * BM + wr * 64 + fr, col0 = u.pn * BM + wc * 32 + 4 * fq;
        f32x4 gv[2][2];
#pragma unroll
        for (int bj = 0; bj < 2; ++bj)
#pragma unroll
            for (int n = 0; n < 2; ++n) gv[bj][n] = *(const f32x4*)(gate + col0 + bj * HALF + n * 16) * gs;
#pragma unroll
        for (int ai = 0; ai < 2; ++ai)
#pragma unroll
            for (int m = 0; m < 4; ++m) { float* rowp = H + (size_t)(row0 + ai * HALF + m * 16) * ldc + col0;
#pragma unroll
                for (int bj = 0; bj < 2; ++bj)
#pragma unroll
                    for (int n = 0; n < 2; ++n) { f32x4* p = (f32x4*)(rowp + bj * HALF + n * 16); *p = *p + gv[bj][n] * acc[ai][bj][m][n]; }
                asm volatile("" ::: "memory"); }
    }
};
struct EpiIn {
    static constexpr bool PERM = true, AFTER_DRAIN = false;
    bf16_t* O; int ldc; const float* tab; int rope_rows, rope_tiles, gate_tile0;
    __device__ __forceinline__ void operator()(const f32x4 (&acc)[2][2][4][2], const Unit& u, int wr, int wc, int fr, int fq) const {
        const int row0 = u.pm * BM + wr * 64 + fr, col0 = u.pn * BM + wc * 32 + 8 * fq;
        const int mode = (u.pn < rope_tiles && u.pm * BM < rope_rows) ? 1 : (u.pn >= gate_tile0 ? 2 : 0);
        const int axis = wc >> 1, pi0 = 16 * (wc & 1) + 4 * fq;
#pragma unroll
        for (int ai = 0; ai < 2; ++ai)
#pragma unroll
            for (int m = 0; m < 4; ++m) { const int r = row0 + ai * HALF + m * 16; bf16_t* rowp = O + (size_t)r * ldc + col0;
                f32x4 cs0 = {1.f, 0.f, 1.f, 0.f}, cs1 = {1.f, 0.f, 1.f, 0.f};
                if (mode == 1) { const int pos = axis ? (r & 63) : (r >> 6); const float* tp = tab + (size_t)(pos * 32 + pi0) * 2; cs0 = *(const f32x4*)tp; cs1 = *(const f32x4*)(tp + 4); }
#pragma unroll
                for (int bj = 0; bj < 2; ++bj) { f32x4 v0 = acc[ai][bj][m][0], v1 = acc[ai][bj][m][1];
                    if (mode == 1) { const f32x4 t1 = v0, t2 = v1;
                        v0[0] = t1[0] * cs0[0] - t2[0] * cs0[1]; v1[0] = t2[0] * cs0[0] + t1[0] * cs0[1];
                        v0[1] = t1[1] * cs0[2] - t2[1] * cs0[3]; v1[1] = t2[1] * cs0[2] + t1[1] * cs0[3];
                        v0[2] = t1[2] * cs1[0] - t2[2] * cs1[1]; v1[2] = t2[2] * cs1[0] + t1[2] * cs1[1];
                        v0[3] = t1[3] * cs1[2] - t2[3] * cs1[3]; v1[3] = t2[3] * cs1[2] + t1[3] * cs1[3]; }
                    else if (mode == 2) {
#pragma unroll
                        for (int i = 0; i < 4; ++i) { v0[i] = fast_sigmoid(v0[i]); v1[i] = fast_sigmoid(v1[i]); } }
                    u32x4 w; w.x = cvt_pk_bf16(v0[0], v0[1]); w.y = cvt_pk_bf16(v0[2], v0[3]); w.z = cvt_pk_bf16(v1[0], v1[1]); w.w = cvt_pk_bf16(v1[2], v1[3]);
                    *(u32x4*)(rowp + bj * HALF) = w; } }
    }
};
struct EpiMerge {
    static constexpr bool PERM = true, AFTER_DRAIN = false;
    const bf16_t* G; int ldg; int gate_off; float* S; bf16_t* O; int ldc;
    __device__ __forceinline__ void operator()(const f32x4 (&acc)[2][2][4][2], const Unit& u, int wr, int wc, int fr, int fq) const {
        const int row0 = u.pm * BM + wr * 64 + fr, col0 = u.pn * BM + wc * 32 + 8 * fq; const int seg = u.seg;
#pragma unroll
        for (int ai = 0; ai < 2; ++ai)
#pragma unroll
            for (int m = 0; m < 4; ++m) { const int r = row0 + ai * HALF + m * 16;
#pragma unroll
                for (int bj = 0; bj < 2; ++bj) { const int c = col0 + bj * HALF;
                    const u32x4 gw = *(const u32x4*)(G + (size_t)r * ldg + gate_off + seg * ldc + c);
                    f32x4 g0, g1; g0[0] = __builtin_bit_cast(float, gw.x << 16); g0[1] = __builtin_bit_cast(float, gw.x & 0xffff0000u); g0[2] = __builtin_bit_cast(float, gw.y << 16); g0[3] = __builtin_bit_cast(float, gw.y & 0xffff0000u);
                    g1[0] = __builtin_bit_cast(float, gw.z << 16); g1[1] = __builtin_bit_cast(float, gw.z & 0xffff0000u); g1[2] = __builtin_bit_cast(float, gw.w << 16); g1[3] = __builtin_bit_cast(float, gw.w & 0xffff0000u);
                    f32x4 v0 = acc[ai][bj][m][0] * g0, v1 = acc[ai][bj][m][1] * g1; float* sp = S + (size_t)r * ldc + c;
                    if (seg > 0) { v0 += *(const f32x4*)sp; v1 += *(const f32x4*)(sp + 4); }
                    if (seg < 2) { *(f32x4*)sp = v0; *(f32x4*)(sp + 4) = v1; }
                    else { u32x4 w; w.x = cvt_pk_bf16(v0[0], v0[1]); w.y = cvt_pk_bf16(v0[2], v0[3]); w.z = cvt_pk_bf16(v1[0], v1[1]); w.w = cvt_pk_bf16(v1[2], v1[3]); *(u32x4*)(O + (size_t)r * ldc + c) = w; } }
                asm volatile("" ::: "memory"); }
    }
};
struct SegOrder : StaticOrder {
    __device__ __forceinline__ bool next(int i, Unit& u) const { const int t = i / 3; if (!StaticOrder::next(t, u)) return false; u.seg = i - 3 * t; return true; }
    __device__ __forceinline__ int koff(const Unit& u) const { return u.seg == 0 ? 0 : (u.seg == 1 ? 2048 : 3072); }
    __device__ __forceinline__ int nt(const Unit& u) const { return u.seg == 0 ? 32 : 16; }
};

template <class Epi, class Sched, bool ALIGN_EPI = false, bool SP2 = false>
__device__ __forceinline__ void gemm_phase(PG8_LAS unsigned char* lds, const Gemm g, const Sched& S, const Epi& E, int tid_in) {
    int tid_ = tid_in; asm volatile("" : "+v"(tid_));
    const int tid = tid_, wid = __builtin_amdgcn_readfirstlane(tid >> 6), lane = tid & 63, wr = wid >> 2, wc = wid & 3, fr = lane & 15, fq = lane >> 4;
    int K_ = g.K; asm volatile("" : "+s"(K_)); const int K = K_; int nt;
    unsigned voffA[2], voffB[2];
#pragma unroll
    for (int i = 0; i < 2; ++i) { int R, C; stage_rc(tid * 16 + i * 8192, R, C); const int Rb = Epi::PERM ? ((R & ~31) + perm32(R & 31)) : R;
        voffA[i] = (unsigned)(R * K + C) * 2u; voffB[i] = (unsigned)(Rb * K + C) * 2u; }
    const size_t kstep = (size_t)(BK * 2);
    const size_t hstep = (size_t)HALF * K * 2;
    const size_t tstep = 2 * hstep;
    const unsigned ldsw = (unsigned)wid * 1024u;
    const int aoff = lds_byte(wr * 64 + fr, fq * 8), boff = lds_byte(wc * 32 + fr, fq * 8);
#define PG8_SA(b, h) (((b) * 2 + (h)) * HTB)
#define PG8_SB(b, h) ((4 + (b) * 2 + (h)) * HTB)
#define PG8_STAGE(bufoff, gbase, voff) do { _Pragma("unroll") for (int _i = 0; _i < 2; ++_i) \
        __builtin_amdgcn_global_load_lds((const unsigned*)((const char*)(gbase) + (voff)[_i]), (PG8_LAS unsigned*)(lds + (bufoff) + ldsw + _i * 8192), 16, 0, 0); } while (0)
#define PG8_LDA(dst, b, h) do { _Pragma("unroll") for (int m = 0; m < 4; ++m) _Pragma("unroll") for (int k = 0; k < 2; ++k) dst[m][k] = *(const PG8_LAS bf16x8*)(lds + PG8_SA(b, h) + aoff + m * 2048 + k * 1024); } while (0)
#define PG8_LDB(dst, b, h) do { _Pragma("unroll") for (int n = 0; n < 2; ++n) _Pragma("unroll") for (int k = 0; k < 2; ++k) dst[n][k] = *(const PG8_LAS bf16x8*)(lds + PG8_SB(b, h) + boff + n * 2048 + k * 1024); } while (0)
#define PG8_MMA(ai, bj, At, Bt) do { __builtin_amdgcn_s_setprio(1); _Pragma("unroll") for (int m = 0; m < 4; ++m) _Pragma("unroll") for (int n = 0; n < 2; ++n) _Pragma("unroll") for (int k = 0; k < 2; ++k) \
        acc[ai][bj][m][n] = __builtin_amdgcn_mfma_f32_16x16x32_bf16(Bt[n][k], At[m][k], acc[ai][bj][m][n], 0, 0, 0); __builtin_amdgcn_s_setprio(0); } while (0)
#define PG8_WAIT_V(n) asm volatile("s_waitcnt vmcnt(" #n ")" ::: "memory")
#define PG8_WAIT_L(n) asm volatile("s_waitcnt lgkmcnt(" #n ")" ::: "memory")
#define PG8_BAR __builtin_amdgcn_s_barrier()
#define PG8_SCHED __builtin_amdgcn_sched_barrier(0)
    Unit cur, nxt; int ui = 0;
    if (!S.next(0, cur)) return;
    f32x4 acc[2][2][4][2];
#pragma unroll
    for (int a = 0; a < 2; ++a)
#pragma unroll
        for (int b = 0; b < 2; ++b)
#pragma unroll
            for (int m = 0; m < 4; ++m)
#pragma unroll
                for (int n = 0; n < 2; ++n) acc[a][b][m][n] = (f32x4){0.f, 0.f, 0.f, 0.f};
    bf16x8 At[4][2], B0[2][2], B1[2][2];
    const char* cA = (const char*)g.A + (size_t)cur.pm * tstep + (size_t)S.koff(cur) * 2; const char* cB = (const char*)g.Bt + (size_t)cur.pn * tstep + (size_t)S.koff(cur) * 2; nt = S.nt(cur);
    S.a_ready(cur);
    if constexpr (SP2) {
        PG8_STAGE(PG8_SB(0, 0), cB, voffB); PG8_STAGE(PG8_SB(0, 1), cB + hstep, voffB); PG8_STAGE(PG8_SA(0, 0), cA, voffA); PG8_STAGE(PG8_SA(0, 1), cA + hstep, voffA);
        if (wr == 1) PG8_BAR;
        PG8_WAIT_V(2); PG8_BAR;
        PG8_STAGE(PG8_SB(1, 0), cB + kstep, voffB); PG8_STAGE(PG8_SA(1, 0), cA + kstep, voffA); PG8_STAGE(PG8_SB(1, 1), cB + hstep + kstep, voffB);
        PG8_WAIT_V(6); PG8_BAR;
    } else {
        PG8_STAGE(PG8_SB(0, 0), cB, voffB); PG8_STAGE(PG8_SA(0, 0), cA, voffA); PG8_STAGE(PG8_SB(0, 1), cB + hstep, voffB); PG8_STAGE(PG8_SA(0, 1), cA + hstep, voffA);
        if (wr == 1) PG8_BAR;
        PG8_WAIT_V(4); PG8_BAR;
        PG8_STAGE(PG8_SB(1, 0), cB + kstep, voffB); PG8_STAGE(PG8_SA(1, 0), cA + kstep, voffA); PG8_STAGE(PG8_SB(1, 1), cB + hstep + kstep, voffB);
        PG8_WAIT_V(6); PG8_BAR;
    }
    for (;;) {
        const bool has_next = S.next(ui + 1, nxt);
        const char* nA = has_next ? (const char*)g.A + (size_t)nxt.pm * tstep + (size_t)S.koff(nxt) * 2 : cA; const char* nB = has_next ? (const char*)g.Bt + (size_t)nxt.pn * tstep + (size_t)S.koff(nxt) * 2 : cB;
        for (int t = 0; t < nt; t += 2) {
            const bool last = (t == nt - 2);
            const char* a1 = cA + (size_t)(t + 1) * kstep;
            const char* a2 = last ? nA : cA + (size_t)(t + 2) * kstep; const char* b2 = last ? nB : cB + (size_t)(t + 2) * kstep;
            const char* a3 = a2 + kstep; const char* b3 = b2 + kstep;
            if (last && has_next) S.a_ready(nxt);
            if constexpr (SP2) {
            PG8_LDB(B0, 0, 0); PG8_LDB(B1, 0, 1); PG8_SCHED; PG8_LDA(At, 0, 0); PG8_STAGE(PG8_SA(1, 1), a1 + hstep, voffA);
            PG8_WAIT_V(8); PG8_WAIT_L(0); PG8_BAR; PG8_MMA(0, 0, At, B0); PG8_MMA(0, 1, At, B1); PG8_BAR; PG8_SCHED;
            PG8_LDA(At, 0, 1); PG8_STAGE(PG8_SB(0, 0), b2, voffB); PG8_STAGE(PG8_SB(0, 1), b2 + hstep, voffB); PG8_STAGE(PG8_SA(0, 0), a2, voffA);
            PG8_WAIT_V(8); PG8_WAIT_L(0); PG8_BAR; PG8_MMA(1, 0, At, B0); PG8_MMA(1, 1, At, B1); PG8_BAR; PG8_SCHED;
            PG8_LDB(B0, 1, 0); PG8_LDB(B1, 1, 1); PG8_SCHED; PG8_LDA(At, 1, 0); PG8_STAGE(PG8_SA(0, 1), a2 + hstep, voffA);
            PG8_WAIT_V(8); PG8_WAIT_L(0); PG8_BAR; PG8_MMA(0, 0, At, B0); PG8_MMA(0, 1, At, B1); PG8_BAR; PG8_SCHED;
            PG8_LDA(At, 1, 1); PG8_STAGE(PG8_SB(1, 0), b3, voffB); PG8_STAGE(PG8_SB(1, 1), b3 + hstep, voffB); PG8_STAGE(PG8_SA(1, 0), a3, voffA);
            PG8_WAIT_V(8); PG8_WAIT_L(0); PG8_BAR; PG8_MMA(1, 0, At, B0); PG8_MMA(1, 1, At, B1); PG8_BAR; PG8_SCHED;
            } else {
            PG8_LDB(B0, 0, 0); PG8_SCHED; PG8_LDA(At, 0, 0); PG8_STAGE(PG8_SA(1, 1), a1 + hstep, voffA);
            PG8_WAIT_L(8); PG8_BAR; PG8_WAIT_L(0); PG8_MMA(0, 0, At, B0); PG8_BAR; PG8_SCHED;
            PG8_LDB(B1, 0, 1); PG8_STAGE(PG8_SB(0, 0), b2, voffB);
            PG8_BAR; PG8_WAIT_L(0); PG8_MMA(0, 1, At, B1); PG8_BAR;
            PG8_LDA(At, 0, 1); PG8_STAGE(PG8_SA(0, 0), a2, voffA);
            PG8_BAR; PG8_WAIT_L(0); PG8_MMA(1, 0, At, B0); PG8_BAR; PG8_SCHED;
            PG8_STAGE(PG8_SB(0, 1), b2 + hstep, voffB);
            PG8_WAIT_V(6); PG8_BAR; PG8_MMA(1, 1, At, B1); PG8_BAR;
            PG8_LDB(B0, 1, 0); PG8_SCHED; PG8_LDA(At, 1, 0); PG8_STAGE(PG8_SA(0, 1), a2 + hstep, voffA);
            PG8_WAIT_L(8); PG8_BAR; PG8_WAIT_L(0); PG8_MMA(0, 0, At, B0); PG8_BAR; PG8_SCHED;
            PG8_LDB(B1, 1, 1); PG8_STAGE(PG8_SB(1, 0), b3, voffB);
            PG8_BAR; PG8_WAIT_L(0); PG8_MMA(0, 1, At, B1); PG8_BAR;
            PG8_LDA(At, 1, 1); PG8_STAGE(PG8_SA(1, 0), a3, voffA);
            PG8_BAR; PG8_WAIT_L(0); PG8_MMA(1, 0, At, B0); PG8_BAR; PG8_SCHED;
            PG8_STAGE(PG8_SB(1, 1), b3 + hstep, voffB);
            PG8_WAIT_V(6); PG8_BAR; PG8_MMA(1, 1, At, B1); PG8_BAR;
            }
        }
        if constexpr (ALIGN_EPI) { if (wr == 0) PG8_BAR; }
        if constexpr (!Epi::AFTER_DRAIN) { E(acc, cur, wr, wc, fr, fq); S.done(cur); }
        if (!has_next) break;
#pragma unroll
        for (int a = 0; a < 2; ++a)
#pragma unroll
            for (int b = 0; b < 2; ++b)
#pragma unroll
                for (int m = 0; m < 4; ++m)
#pragma unroll
                    for (int n = 0; n < 2; ++n) acc[a][b][m][n] = (f32x4){0.f, 0.f, 0.f, 0.f};
        cur = nxt; cA = nA; cB = nB; ++ui; nt = S.nt(cur);
        if constexpr (ALIGN_EPI) { if (wr == 1) PG8_BAR; }
    }
    PG8_WAIT_V(0);
    if constexpr (!ALIGN_EPI) { if (wr == 0) PG8_BAR; }
    PG8_BAR;
    if constexpr (Epi::AFTER_DRAIN) { E.fused(acc, cur, wr, wc, fr, fq, lds, wid, lane); S.done(cur); }
#undef PG8_SA
#undef PG8_SB
#undef PG8_STAGE
#undef PG8_LDA
#undef PG8_LDB
#undef PG8_MMA
#undef PG8_WAIT_V
#undef PG8_WAIT_L
#undef PG8_BAR
#undef PG8_SCHED
}
}


namespace att {
typedef unsigned short bf16;
constexpr int D = 128, NW = 8, QBLK = 32, KVBLK = 64;
constexpr float SCALE = 0.088388347648318440f;
constexpr float THR = 8.f;
constexpr int SDEPTH = 1;
constexpr size_t SHM_V = KVBLK * D * 2, SHM_K = KVBLK * D * 2, SHM_ATTN = 2 * SHM_V + 2 * SHM_K + NW * 64 * 4;
using bf16x8 = __attribute__((ext_vector_type(8))) short;
using s16x4  = __attribute__((ext_vector_type(4))) short;
using f32x16 = __attribute__((ext_vector_type(16))) float;
using u32x4  = __attribute__((ext_vector_type(4))) unsigned;
#define KSWZ(row, colB) ((row) * 256 + ((colB) ^ (((row) & 7) << 4)))
#define SBAR() __builtin_amdgcn_sched_barrier(0)
__device__ __forceinline__ int crow(int r, int hi) { return (r & 3) + 8 * (r >> 2) + 4 * hi; }
__device__ __forceinline__ unsigned cvtpk(float lo, float hi) {
  unsigned r; asm volatile("v_cvt_pk_bf16_f32 %0, %1, %2" : "=v"(r) : "v"(lo), "v"(hi)); return r;
}
__device__ __forceinline__ void partialSM(f32x16& p0, f32x16& p1, float& m_reg, float& mn, float& alpha) {
  constexpr float C = SCALE * 1.4426950408889634f;
  float pmax = p0[0]; for (int r = 1; r < 16; ++r) pmax = fmaxf(pmax, p0[r]); for (int r = 0; r < 16; ++r) pmax = fmaxf(pmax, p1[r]);
  { auto rr = __builtin_amdgcn_permlane32_swap(__float_as_uint(pmax), __float_as_uint(pmax), false, false);
    pmax = fmaxf(__uint_as_float(rr[0]), __uint_as_float(rr[1])); }
  if (__builtin_expect(__all(pmax - m_reg <= THR / SCALE), 1)) { mn = m_reg; alpha = 1.f; }
  else { mn = fmaxf(m_reg, pmax); alpha = __builtin_amdgcn_exp2f((m_reg - mn) * C); m_reg = mn; }
  float mnC = -mn * C;
  for (int r = 0; r < 16; ++r) p0[r] = fmaf(p0[r], C, mnC); for (int r = 0; r < 16; ++r) p1[r] = fmaf(p1[r], C, mnC);
  for (int r = 0; r < 16; ++r) p0[r] = __builtin_amdgcn_exp2f(p0[r]);
}
__device__ __forceinline__ void finishSM(f32x16& p0, f32x16& p1, float alpha, float& l_reg, bf16x8& pa0, bf16x8& pa1, bf16x8& pa2, bf16x8& pa3) {
  for (int r = 0; r < 16; ++r) p1[r] = __builtin_amdgcn_exp2f(p1[r]);
  float ps = 0; for (int r = 0; r < 16; ++r) ps += p0[r]; for (int r = 0; r < 16; ++r) ps += p1[r];
  { auto rr = __builtin_amdgcn_permlane32_swap(__float_as_uint(ps), __float_as_uint(ps), false, false);
    ps = __uint_as_float(rr[0]) + __uint_as_float(rr[1]); }
  l_reg = l_reg * alpha + ps;
#define PK4(P, BASE, OUT) do { unsigned a0 = cvtpk(P[BASE + 0], P[BASE + 1]), a1 = cvtpk(P[BASE + 2], P[BASE + 3]);   \
    unsigned b0 = cvtpk(P[BASE + 4], P[BASE + 5]), b1 = cvtpk(P[BASE + 6], P[BASE + 7]);                              \
    auto r0 = __builtin_amdgcn_permlane32_swap(a0, b0, false, false); auto r1 = __builtin_amdgcn_permlane32_swap(a1, b1, false, false); \
    u32x4 w = {r0[0], r1[0], r0[1], r1[1]}; OUT = *reinterpret_cast<bf16x8*>(&w); } while (0)
  PK4(p0, 0, pa0); PK4(p0, 8, pa1); PK4(p1, 0, pa2); PK4(p1, 8, pa3);
#undef PK4
}
__device__ __forceinline__ void qkt(f32x16& p0, f32x16& p1, const bf16* Ks, const bf16x8* qr, int r32, int hi) {
  p0 = f32x16{}; p1 = f32x16{};
  for (int d0 = 0; d0 < 8; ++d0) { int cb = (d0 * 16 + hi * 8) * 2;
    bf16x8 b0 = *reinterpret_cast<const bf16x8*>((const char*)Ks + KSWZ(r32, cb));
    bf16x8 b1 = *reinterpret_cast<const bf16x8*>((const char*)Ks + KSWZ(32 + r32, cb));
    p0 = __builtin_amdgcn_mfma_f32_32x32x16_bf16(b0, qr[d0], p0, 0, 0, 0);
    p1 = __builtin_amdgcn_mfma_f32_32x32x16_bf16(b1, qr[d0], p1, 0, 0, 0); }
}
__device__ __forceinline__ int v_st(int k, int c) { const int kk = (k & ~0xC) | ((k & 4) << 1) | ((k & 8) >> 1); return ((kk >> 3) * 4 + (c >> 5)) * 512 + ((kk & 7) * 32 + (c & 31)) * 2; }
__device__ __forceinline__ int v_rd_base(int lane) { return ((lane & 3) << 3) | (((lane >> 2) & 3) << 6) | (((lane >> 4) & 1) << 5) | (((lane >> 5) & 1) << 8); }
constexpr int v_rd_off(int d0, int ks, int half) { return d0 * 512 + ks * 4096 + half * 2048; }
template <int OFF> __device__ __forceinline__ s16x4 tr_read(int vb) {
  s16x4 r; asm volatile("ds_read_b64_tr_b16 %0, %1 offset:%2" : "=&v"(r) : "v"(vb), "i"(OFF) : "memory"); return r;
}
template <int D0> __device__ __forceinline__ void pv_one(f32x16& od, int vb, bf16x8 pa0, bf16x8 pa1, bf16x8 pa2, bf16x8 pa3) {
  const s16x4 l0 = tr_read<v_rd_off(D0, 0, 0)>(vb), h0 = tr_read<v_rd_off(D0, 0, 1)>(vb), l1 = tr_read<v_rd_off(D0, 1, 0)>(vb), h1 = tr_read<v_rd_off(D0, 1, 1)>(vb);
  const s16x4 l2 = tr_read<v_rd_off(D0, 2, 0)>(vb), h2 = tr_read<v_rd_off(D0, 2, 1)>(vb), l3 = tr_read<v_rd_off(D0, 3, 0)>(vb), h3 = tr_read<v_rd_off(D0, 3, 1)>(vb);
  asm volatile("s_waitcnt lgkmcnt(0)" ::: "memory"); SBAR();
#define PK(L, H) (bf16x8){L[0], L[1], L[2], L[3], H[0], H[1], H[2], H[3]}
  od = __builtin_amdgcn_mfma_f32_32x32x16_bf16(pa0, PK(l0, h0), od, 0, 0, 0);
  od = __builtin_amdgcn_mfma_f32_32x32x16_bf16(pa1, PK(l1, h1), od, 0, 0, 0);
  od = __builtin_amdgcn_mfma_f32_32x32x16_bf16(pa2, PK(l2, h2), od, 0, 0, 0);
  od = __builtin_amdgcn_mfma_f32_32x32x16_bf16(pa3, PK(l3, h3), od, 0, 0, 0);
#undef PK
}
__device__ __forceinline__ void pv_d0(f32x16* o, int vb, bf16x8 pa0, bf16x8 pa1, bf16x8 pa2, bf16x8 pa3) {
  pv_one<0>(o[0], vb, pa0, pa1, pa2, pa3); pv_one<1>(o[1], vb, pa0, pa1, pa2, pa3); pv_one<2>(o[2], vb, pa0, pa1, pa2, pa3); pv_one<3>(o[3], vb, pa0, pa1, pa2, pa3);
}


__device__ __forceinline__ void band_mask(f32x16& p0, f32x16& p1, int kind, int off, int i, int hi) {
  const int th = i - off - 4 * hi;
  if (kind == 1) {
#pragma unroll
    for (int r = 0; r < 16; ++r) { const int k0 = (r & 3) + 8 * (r >> 2); p0[r] = (k0 < th) ? -1e30f : p0[r]; p1[r] = (32 + k0 < th) ? -1e30f : p1[r]; } }
  else if (kind == 2) {
#pragma unroll
    for (int r = 0; r < 16; ++r) { const int k0 = (r & 3) + 8 * (r >> 2); p0[r] = (k0 > th) ? -1e30f : p0[r]; p1[r] = (32 + k0 > th) ? -1e30f : p1[r]; } }
}
constexpr int NQB = 64, LROWS = 8192;
__device__ __forceinline__ void tile_info(int qb, int t, int& row, int& kind, int& off) {
  kind = 0; off = 0;
  if (qb >= NQB) { row = LROWS + 64 * t; return; }
  if (t < 2) { row = qb * 128 + 64 * t; return; }
  if (t < 6) { row = LROWS + 64 * (t - 2); return; }
  int tt = t - 6; const bool prev = (qb > 0) && (tt < 2); if (!prev && qb > 0) tt -= 2;
  off = 64 * tt; if (prev) { row = (qb - 1) * 128 + off; kind = 1; } else { row = (qb + 1) * 128 + off; kind = 2; }
}
__device__ __forceinline__ void attn_unit(const bf16* __restrict__ P, int ldp, int qoff, int koff, int voff, bf16* __restrict__ O, int ldo, int qb, int kvh, int hq0, const float* __restrict__ sink, char* lds, int tid) {
  const int wid = __builtin_amdgcn_readfirstlane(tid >> 6), lane = tid & 63, r32 = lane & 31, hi = lane >> 5;
  const int hq = hq0 + (wid >> 2), iq = (wid & 3) * 32 + r32;
  bf16* V_lds = (bf16*)lds; bf16* K_lds = (bf16*)(lds + 2 * SHM_V);
  float* ws = (float*)(lds + 2 * SHM_V + 2 * SHM_K) + wid * 64; float* li_l = ws; float* al_l = ws + 32;
  float m_reg = -1e30f, l_reg = 0; f32x16 o[4] = {}; bf16x8 qr[8];
  const bf16* Qw = P + (size_t)(qb * 128 + iq) * ldp + qoff + hq * 128 + hi * 8;
#pragma unroll
  for (int d0 = 0; d0 < 8; ++d0) qr[d0] = *reinterpret_cast<const bf16x8*>(Qw + d0 * 16);
  const int sr = tid >> 4, sc = (tid & 15) * 8, vst0 = v_st(sr, sc), vst1 = v_st(32 + sr, sc);
  const int vb0 = (int)(uintptr_t)V_lds + v_rd_base(lane);
  const bf16* Kg = P + koff + kvh * 128 + sc; const bf16* Vg = P + voff + kvh * 128 + sc;
  struct { bf16x8 vs0, vs1, ks0, ks1; } sr_[SDEPTH];
  const int NT = (qb >= NQB) ? 4 : 6 + (qb > 0 ? 2 : 0) + (qb < NQB - 1 ? 2 : 0);
  int trow, tkind, toff;
#define SLOAD(i, t) do { int kd_, of_; tile_info(qb, (t), trow, kd_, of_); const unsigned r0_ = (unsigned)(trow + sr) * (unsigned)ldp, r1_ = r0_ + 32u * (unsigned)ldp; \
    sr_[i].vs0 = *reinterpret_cast<const bf16x8*>(Vg + r0_); sr_[i].vs1 = *reinterpret_cast<const bf16x8*>(Vg + r1_); \
    sr_[i].ks0 = *reinterpret_cast<const bf16x8*>(Kg + r0_); sr_[i].ks1 = *reinterpret_cast<const bf16x8*>(Kg + r1_); } while (0)
#define SWRITE(b, i) do { *(bf16x8*)((char*)V_lds + (b) * SHM_V + vst0) = sr_[i].vs0;          \
    *(bf16x8*)((char*)V_lds + (b) * SHM_V + vst1) = sr_[i].vs1; int kc = sc * 2;               \
    *(bf16x8*)((char*)K_lds + (b) * SHM_K + KSWZ(sr, kc)) = sr_[i].ks0;                       \
    *(bf16x8*)((char*)K_lds + (b) * SHM_K + KSWZ(32 + sr, kc)) = sr_[i].ks1; } while (0)
#define SWAIT() do { if constexpr (SDEPTH == 2) asm volatile("s_waitcnt vmcnt(4)" ::: "memory"); else asm volatile("s_waitcnt vmcnt(0)" ::: "memory"); } while (0)
#define RESC(a) do { if (__any((a) < 1.f)) { if (hi == 0) al_l[r32] = (a); asm volatile("s_waitcnt lgkmcnt(0)" ::: "memory"); \
    for (int d = 0; d < 4; ++d) for (int r = 0; r < 16; ++r) o[d][r] *= al_l[crow(r, hi)]; } } while (0)
#define MASK(p0, p1, t) do { tile_info(qb, (t), trow, tkind, toff); if (tkind) band_mask(p0, p1, tkind, toff, iq, hi); } while (0)
  f32x16 pA0, pA1, pB0, pB1; float mnA, mnB, alA, alB; bf16x8 pa0, pa1, pa2, pa3;
  constexpr int SE = 0, SO = SDEPTH - 1;
  SLOAD(SE, 0); asm volatile("s_waitcnt vmcnt(0)" ::: "memory"); SWRITE(0, SE); __syncthreads();
  qkt(pA0, pA1, K_lds, qr, r32, hi); partialSM(pA0, pA1, m_reg, mnA, alA);
  SLOAD(SO, 1); if constexpr (SDEPTH == 2) { if (2 < NT) SLOAD(SE, 2); }
  SWAIT(); SWRITE(1, SO); __syncthreads();
  for (int j = 1; j + 1 < NT; j += 2) {
    SBAR(); qkt(pB0, pB1, (bf16*)((char*)K_lds + SHM_K), qr, r32, hi); MASK(pB0, pB1, j);
    finishSM(pA0, pA1, alA, l_reg, pa0, pa1, pa2, pa3); SBAR();
    SLOAD(SO, j + SDEPTH); SBAR();
    pv_d0(o, vb0, pa0, pa1, pa2, pa3); partialSM(pB0, pB1, m_reg, mnB, alB);
    __syncthreads(); SWAIT(); SWRITE(0, SE);
    RESC(alB); __syncthreads();
    SBAR(); qkt(pA0, pA1, K_lds, qr, r32, hi); MASK(pA0, pA1, j + 1);
    finishSM(pB0, pB1, alB, l_reg, pa0, pa1, pa2, pa3); SBAR();
    if (SDEPTH == 1 || j + 3 < NT) SLOAD(SE, j + 1 + SDEPTH); SBAR();
    pv_d0(o, vb0 + (int)SHM_V, pa0, pa1, pa2, pa3); partialSM(pA0, pA1, m_reg, mnA, alA);
    __syncthreads(); SWAIT(); SWRITE(1, SO);
    RESC(alA); __syncthreads();
  }
  SBAR(); qkt(pB0, pB1, (bf16*)((char*)K_lds + SHM_K), qr, r32, hi); MASK(pB0, pB1, NT - 1);
  finishSM(pA0, pA1, alA, l_reg, pa0, pa1, pa2, pa3); SBAR();
  pv_d0(o, vb0, pa0, pa1, pa2, pa3); partialSM(pB0, pB1, m_reg, mnB, alB);
  __syncthreads(); RESC(alB);
  finishSM(pB0, pB1, alB, l_reg, pa0, pa1, pa2, pa3); SBAR();
  pv_d0(o, vb0 + (int)SHM_V, pa0, pa1, pa2, pa3);
  { constexpr float C = SCALE * 1.4426950408889634f; l_reg += __builtin_amdgcn_exp2f(sink[hq] * 1.4426950408889634f - m_reg * C); }
  if (hi == 0) li_l[r32] = l_reg; asm volatile("s_waitcnt lgkmcnt(0)" ::: "memory");
  float rli[16];
#pragma unroll
  for (int r = 0; r < 16; ++r) rli[r] = __builtin_amdgcn_rcpf(li_l[crow(r, hi)]);
  bf16* Ow = O + (size_t)(qb * 128 + (wid & 3) * 32) * ldo + hq * 128;
#pragma unroll
  for (int r = 0; r < 16; ++r) { const int orow = crow(r, hi);
#pragma unroll
    for (int d0 = 0; d0 < 4; ++d0) { const float v = o[d0][r] * rli[r]; unsigned u = __builtin_bit_cast(unsigned, v); u = (u + 0x7fffu + ((u >> 16) & 1u)) >> 16; Ow[(size_t)orow * ldo + d0 * 32 + r32] = (bf16)u; } }
#undef SLOAD
#undef SWRITE
#undef SWAIT
#undef RESC
#undef MASK
}
#undef KSWZ
#undef SBAR
}

constexpr int NWAVES = 8;
constexpr int D = 2048, L = 8192, LC = 256, MALL = L + LC, FF = 5632, NIN = 13312, NMOD = 9;
constexpr int HD = 128, NQH = 16, NKVH = 4;
constexpr int Q_OFF = 0, K_OFF = 2048, V_OFF = 2560, POOL_OFF = 3072, CB_OFF = 4096, CC_OFF = 5120, CX_OFF = 6144, GATE_OFF = 7168;
constexpr int KCAT = 4096;
constexpr float EPS = 1e-6f;
constexpr int NLAYER = 2, NPL = 11, NPHASE = 1 + NLAYER * NPL + 1;

constexpr size_t MiB = 1u << 20;
constexpr size_t WS_CTL = 0, CTL_ZERO_BYTES = 1 * MiB;
constexpr size_t WS_MODS = 1 * MiB;
constexpr size_t WS_ROPE = 1 * MiB + 512 * 1024;
constexpr size_t WS_W = 2 * MiB, W_LAYER = 208 * MiB;
constexpr size_t W_WI1 = 0, W_WO1 = 44 * MiB, W_WIN = 66 * MiB, W_WMRG = 118 * MiB, W_WOUT = 134 * MiB, W_WI2 = 142 * MiB, W_WO2 = 186 * MiB;
constexpr size_t WS_H = 418 * MiB;
constexpr size_t WS_XN = 484 * MiB;
constexpr size_t WS_ACT = 517 * MiB;
constexpr size_t WS_P = 608 * MiB;
constexpr size_t WS_ACAT = 823 * MiB;
constexpr size_t WS_Y3 = 889 * MiB;
constexpr size_t WS_MRG = 988 * MiB;
constexpr size_t WS_C = 1021 * MiB;
constexpr size_t WS_END = 1087 * MiB;
static_assert((size_t)MALL * NIN * 2 <= 215 * MiB && (size_t)MALL * FF * 2 <= 91 * MiB && (size_t)MALL * D * 4 <= 66 * MiB && (size_t)MALL * D * 2 <= 33 * MiB, "d_ws map");
constexpr int CW_Q = 1024;
constexpr int CW_BAR = 4096;

constexpr int RING_OFF = 0, RING_BYTES = 131072;
constexpr int LDSCTL_OFF = RING_BYTES, MISC_OFF = LDSCTL_OFF + 320;
constexpr int LDS_BYTES = 147456;

#define GAS __attribute__((address_space(1)))
#define LAS __attribute__((address_space(3)))
typedef unsigned short bf16;
typedef unsigned v4u __attribute__((ext_vector_type(4)));
typedef unsigned v2u __attribute__((ext_vector_type(2)));
typedef float f32x4 __attribute__((ext_vector_type(4)));
typedef float f32x2 __attribute__((ext_vector_type(2)));
typedef GAS unsigned gu32;
#define RLX_AGENT __ATOMIC_RELAXED, __HIP_MEMORY_SCOPE_AGENT
#define LDS_WAIT() asm volatile("s_waitcnt lgkmcnt(0)" ::: "memory")
#define VM_WAIT() asm volatile("s_waitcnt vmcnt(0)" ::: "memory")
__device__ __forceinline__ unsigned f2bf(float f) { unsigned u = __builtin_bit_cast(unsigned, f); return (u + 0x7fffu + ((u >> 16) & 1u)) >> 16; }
__device__ __forceinline__ unsigned pk2(float lo, float hi) { return f2bf(lo) | (f2bf(hi) << 16); }
__device__ __forceinline__ float bflo(unsigned w) { return __builtin_bit_cast(float, w << 16); }
__device__ __forceinline__ float bfhi(unsigned w) { return __builtin_bit_cast(float, w & 0xffff0000u); }
__device__ __forceinline__ float bf2f(bf16 b) { return __builtin_bit_cast(float, (unsigned)b << 16); }
__device__ __forceinline__ float sigmoidf_(float x) { return 1.0f / (1.0f + __expf(-x)); }
__device__ __forceinline__ float siluf_(float x) { return x / (1.0f + __expf(-x)); }

#define XB_TMO      128
#define XB_XCNT(j)  (256  + 64 * (j))
#define XB_XSUB(j)  (1280 + 64 * (j))
#define XB_XGEN(j)  (2304 + 64 * (j))
#define XB_TOP      3328
#define XB_TOPGEN   3392
#define XCD_BAR_WORDS 3456
#define XB_SPIN_CAP (1u << 18)

__device__ __forceinline__ unsigned xb_ld(unsigned* p)              { return __hip_atomic_load(p, __ATOMIC_RELAXED, __HIP_MEMORY_SCOPE_AGENT); }
__device__ __forceinline__ unsigned xb_add(unsigned* p, unsigned v) { return __hip_atomic_fetch_add(p, v, __ATOMIC_RELAXED, __HIP_MEMORY_SCOPE_AGENT); }
__device__ __forceinline__ unsigned xb_xcc_id() { return (unsigned)__builtin_amdgcn_s_getreg((3 << 11) | 20) & 0xFu; }
#define XB_SPIN(cond, bar) do { unsigned _sp = 0; while (cond) { __builtin_amdgcn_s_sleep(1); \
    if ((++_sp & 255u) == 0u) { if (xb_ld(&(bar)[XB_TMO])) break; if (_sp > XB_SPIN_CAP) { atomicAdd(&(bar)[XB_TMO], 1u); break; } } } } while (0)

struct XcdBarrier {
    unsigned* bar; unsigned x;
    volatile LAS unsigned* st;
};

__device__ __forceinline__ XcdBarrier xcd_barrier_post(unsigned* bar, volatile LAS unsigned* st, int tid) {
    XcdBarrier b; b.bar = bar; b.x = xb_xcc_id(); b.st = st;
    if (tid == 0) (void)xb_add(&bar[XB_XCNT(b.x)], 1u);
    return b;
}
__device__ __forceinline__ void xcd_barrier_complete(unsigned* bar, unsigned x, unsigned& nloc, unsigned& nx) {
    const unsigned G = gridDim.x * gridDim.y * gridDim.z;
    unsigned sum, cnt, mine, sp = 0u;
    for (;;) {
        sum = 0u; cnt = 0u; mine = 0u;
#pragma unroll
        for (unsigned j = 0; j < 16; ++j) { const unsigned c = xb_ld(&bar[XB_XCNT(j)]); sum += c; cnt += (c > 0u) ? 1u : 0u; mine = (j == x) ? c : mine; }
        if (sum == G) break;
        __builtin_amdgcn_s_sleep(1);
        if ((++sp & 255u) == 0u) { if (xb_ld(&bar[XB_TMO])) break; if (sp > XB_SPIN_CAP) { atomicAdd(&bar[XB_TMO], 1u); break; } }
    }
    nloc = mine > 0u ? mine : 1u; nx = cnt > 0u ? cnt : 1u;
}

__device__ __forceinline__ void xcd_barrier(const XcdBarrier& b, int tid) {
    asm volatile("s_waitcnt vmcnt(0)" ::: "memory");
    __syncthreads();
    if (tid == 0) {
        unsigned* bar = b.bar;
        __builtin_amdgcn_s_waitcnt(0);
        unsigned nloc = b.st[0], nx = b.st[1];
        if (nloc == 0u) { xcd_barrier_complete(bar, b.x, nloc, nx); b.st[0] = nloc; b.st[1] = nx; }
        const unsigned old = xb_add(&bar[XB_XSUB(b.x)], 1u);
        const unsigned gen = old / nloc;
        if (old + 1u == (gen + 1u) * nloc) {
            __builtin_amdgcn_fence(__ATOMIC_RELEASE, "agent");
            asm volatile("s_waitcnt vmcnt(0)" ::: "memory");
            const unsigned og = xb_add(&bar[XB_TOP], 1u);
            const unsigned tg = og / nx;
            if (og + 1u == (tg + 1u) * nx) xb_add(&bar[XB_TOPGEN], 1u);
            else XB_SPIN(xb_ld(&bar[XB_TOPGEN]) == tg, bar);
            __builtin_amdgcn_fence(__ATOMIC_ACQUIRE, "agent");
            xb_add(&bar[XB_XGEN(b.x)], 1u);
            asm volatile("s_waitcnt vmcnt(0)" ::: "memory");
        } else {
            XB_SPIN(xb_ld(&bar[XB_XGEN(b.x)]) == gen, bar);
            __builtin_amdgcn_fence(__ATOMIC_ACQUIRE, "agent");
            asm volatile("s_waitcnt vmcnt(0)" ::: "memory");
        }
    }
    __syncthreads();
}


struct Args { const float* in[21]; float* out; unsigned char* ws; int ph_lo, ph_hi; };
struct Frame {
    LAS unsigned char* lds;
    volatile LAS unsigned* MISC;
    gu32* ctl;
    int tid, wave;
    int vcu, G;
    float* out;
    unsigned char* ws;
};
__device__ __forceinline__ float wave_sum(float v, int lane) {
#pragma unroll
    for (int o = 1; o < 64; o <<= 1) v += __builtin_bit_cast(float, __builtin_amdgcn_ds_bpermute((lane ^ o) << 2, __builtin_bit_cast(int, v)));
    return v;
}
__constant__ float ROPE_INV[32] = {1.f, 0.749894261f, 0.562341332f, 0.421696514f, 0.316227764f, 0.237137377f, 0.177827939f, 0.133352131f, 0.100000001f, 0.0749894157f, 0.0562341325f, 0.0421696529f,
    0.0316227749f, 0.0237137377f, 0.0177827943f, 0.0133352149f, 0.00999999978f, 0.00749894185f, 0.00562341325f, 0.00421696482f, 0.00316227763f, 0.00237137359f, 0.00177827943f, 0.00133352145f,
    0.00100000005f, 0.000749894243f, 0.000562341302f, 0.000421696517f, 0.000316227757f, 0.00023713737f, 0.00017782794f, 0.00013335215f};

template <int MODE> __device__ __forceinline__ int rowmap(int n) {
    if (MODE == 1) { const int bj = n >= FF ? 1 : 0, j = n - bj * FF; return (j >> 7) * 256 + bj * 128 + (j & 127); }
    if (MODE == 2) { if (n >= 2560) return n; const int h = n >> 7, d = n & 127, axis = d >> 6, nn = (d >> 5) & 1, pi = d & 31, wc = axis * 2 + (pi >> 4), fq = (pi >> 2) & 3, i = pi & 3; return h * 128 + 32 * wc + 8 * fq + 4 * nn + i; }
    return n;
}
template <int MODE>
__device__ __forceinline__ void xpose_item(const float* W, int N, bf16* WT, int ldk, int koff, LAS float* scr, int item, int lane) {
    const int nblk = N / 32, kb = item / nblk, nb = item % nblk, k0 = 64 * kb, n0 = 32 * nb;
#pragma unroll 8
    for (int i = 0; i < 32; ++i) { const int kk = 2 * i + (lane >> 5); scr[kk * 33 + (lane & 31)] = W[(size_t)(k0 + kk) * N + n0 + (lane & 31)]; }
    LDS_WAIT(); asm volatile("" ::: "memory");
    const int c = lane & 7;
#pragma unroll
    for (int j = 0; j < 4; ++j) { const int n = (lane >> 3) + 8 * j; const LAS float* s = scr + (8 * c) * 33 + n;
        v4u o; o.x = pk2(s[0 * 33], s[1 * 33]); o.y = pk2(s[2 * 33], s[3 * 33]); o.z = pk2(s[4 * 33], s[5 * 33]); o.w = pk2(s[6 * 33], s[7 * 33]);
        *(GAS v4u*)(WT + (size_t)rowmap<MODE>(n0 + n) * ldk + koff + k0 + 8 * c) = o; }
    LDS_WAIT(); asm volatile("" ::: "memory");
}
__device__ __forceinline__ void sincos_d(double a, float& c, float& s) {
    const double TWO_PI = 6.283185307179586476925, HALF_PI = 1.570796326794896619231;
    const double n = __builtin_rint(a * (1.0 / TWO_PI)); double r = a - n * TWO_PI;
    const double q = __builtin_rint(r * (1.0 / HALF_PI)); const double y = r - q * HALF_PI, y2 = y * y;
    const double sy = y * (1.0 - y2 / 6.0 * (1.0 - y2 / 20.0 * (1.0 - y2 / 42.0 * (1.0 - y2 / 72.0 * (1.0 - y2 / 110.0 * (1.0 - y2 / 156.0 * (1.0 - y2 / 210.0)))))));
    const double cy = 1.0 - y2 / 2.0 * (1.0 - y2 / 12.0 * (1.0 - y2 / 30.0 * (1.0 - y2 / 56.0 * (1.0 - y2 / 90.0 * (1.0 - y2 / 132.0 * (1.0 - y2 / 182.0))))));
    const int qi = ((int)q) & 3;
    const double cc = (qi == 0) ? cy : (qi == 1) ? -sy : (qi == 2) ? -cy : sy;
    const double ss = (qi == 0) ? sy : (qi == 1) ? cy : (qi == 2) ? -sy : -cy;
    c = (float)cc; s = (float)ss;
}

struct CvtJob { const float* src; bf16* dst; int N, ldk, koff, mode, nblocks; };
__device__ __forceinline__ CvtJob cvt_job(const Args& A, unsigned char* ws, int jg) {
    const int l = jg >> 3, j = jg & 7; unsigned char* wl = ws + WS_W + (size_t)l * W_LAYER; CvtJob J;
    switch (j) {
    case 0: J = CvtJob{A.in[7] + (size_t)l * D * 2 * FF, (bf16*)(wl + W_WI1), 2 * FF, D, 0, 1, (D / 256) * (2 * FF / 128)}; break;
    case 1: J = CvtJob{A.in[8] + (size_t)l * FF * D, (bf16*)(wl + W_WO1), D, FF, 0, 0, (FF / 256) * (D / 128)}; break;
    case 2: J = CvtJob{A.in[9] + (size_t)l * D * NIN, (bf16*)(wl + W_WIN), NIN, D, 0, 2, (D / 256) * (NIN / 128)}; break;
    case 3: J = CvtJob{A.in[14] + (size_t)l * D * D, (bf16*)(wl + W_WMRG), D, KCAT, 0, 0, (D / 256) * (D / 128)}; break;
    case 4: J = CvtJob{A.in[16] + (size_t)l * 1024 * D, (bf16*)(wl + W_WMRG), D, KCAT, 3072, 0, (1024 / 256) * (D / 128)}; break;
    case 5: J = CvtJob{A.in[17] + (size_t)l * D * D, (bf16*)(wl + W_WOUT), D, D, 0, 0, (D / 256) * (D / 128)}; break;
    case 6: J = CvtJob{A.in[18] + (size_t)l * D * 2 * FF, (bf16*)(wl + W_WI2), 2 * FF, D, 0, 1, (D / 256) * (2 * FF / 128)}; break;
    default: J = CvtJob{A.in[19] + (size_t)l * FF * D, (bf16*)(wl + W_WO2), D, FF, 0, 0, (FF / 256) * (D / 128)}; break;
    }
    return J;
}
__device__ __forceinline__ int rowmap_rt(int mode, int n) { return mode == 1 ? rowmap<1>(n) : (mode == 2 ? rowmap<2>(n) : n); }
struct CvtBlk { const float* src; bf16* dst; int N, ldk, mode, n0; bool ok; };
__device__ __forceinline__ CvtBlk cvt_decode(const Args& A, unsigned char* ws, int j0, int j1, int b) {
    CvtBlk I; I.ok = false; I.src = nullptr; I.dst = nullptr; I.N = 0; I.ldk = 0; I.mode = 0; I.n0 = 0;
    for (int jg = j0; jg < j1; ++jg) { const CvtJob J = cvt_job(A, ws, jg);
        if (b < J.nblocks) { const int nblk = J.N >> 7, kb = b / nblk, nb = b - kb * nblk; I.src = J.src + (size_t)(256 * kb) * J.N + 128 * nb; I.dst = J.dst + J.koff + 256 * kb; I.N = J.N; I.ldk = J.ldk; I.mode = J.mode; I.n0 = 128 * nb; I.ok = true; break; }
        b -= J.nblocks; }
    return I;
}
constexpr int CVT_PITCH = 528;
__device__ __forceinline__ void cvt_load(const CvtBlk& I, f32x4 (&v)[16], int tid) {
    const float* p = I.src + (size_t)(8 * (tid >> 5)) * I.N + 4 * (tid & 31);
#pragma unroll
    for (int g = 0; g < 2; ++g)
#pragma unroll
        for (int j = 0; j < 8; ++j) v[g * 8 + j] = *(const GAS f32x4*)(p + (size_t)(128 * g + j) * I.N);
}
__device__ __forceinline__ void cvt_to_lds(const f32x4 (&v)[16], LAS unsigned char* tile, int tid) {
    const int n4 = tid & 31, kr = tid >> 5;
#pragma unroll
    for (int g = 0; g < 2; ++g)
#pragma unroll
        for (int e = 0; e < 4; ++e) { v4u o; o.x = pg8::cvt_pk_bf16(v[g * 8 + 0][e], v[g * 8 + 1][e]); o.y = pg8::cvt_pk_bf16(v[g * 8 + 2][e], v[g * 8 + 3][e]);
            o.z = pg8::cvt_pk_bf16(v[g * 8 + 4][e], v[g * 8 + 5][e]); o.w = pg8::cvt_pk_bf16(v[g * 8 + 6][e], v[g * 8 + 7][e]);
            *(LAS v4u*)(tile + (4 * n4 + e) * CVT_PITCH + (kr + 16 * g) * 16) = o; }
}
__device__ __forceinline__ void cvt_from_lds(const CvtBlk& I, LAS unsigned char* tile, int tid) {
    const int kg = tid & 31, nsub = tid >> 5;
#pragma unroll
    for (int i = 0; i < 8; ++i) { const int n = 16 * i + nsub; const v4u o = *(LAS v4u*)(tile + n * CVT_PITCH + kg * 16);
        *(GAS v4u*)(I.dst + (size_t)rowmap_rt(I.mode, I.n0 + n) * I.ldk + 8 * kg) = o; }
}
__device__ __forceinline__ void convert_jobs(Frame& F, const Args& A, int j0, int j1, gu32* qword) {
    int total = 0; for (int jg = j0; jg < j1; ++jg) total += cvt_job(A, F.ws, jg).nblocks;
    LAS unsigned char* tile = F.lds;
    if (F.tid == 0) F.MISC[12] = __hip_atomic_fetch_add(qword, 1u, RLX_AGENT);
    __syncthreads();
    int b = (int)F.MISC[12], par = 1;
    CvtBlk cur = cvt_decode(A, F.ws, j0, j1, b < total ? b : 0); cur.ok = cur.ok && (b < total);
    f32x4 va[16], vb[16];
    if (cur.ok) cvt_load(cur, va, F.tid);
    while (cur.ok) {
        if (F.tid == 0) F.MISC[12 + par] = __hip_atomic_fetch_add(qword, 1u, RLX_AGENT);
        cvt_to_lds(va, tile, F.tid);
        __syncthreads();
        b = (int)F.MISC[12 + par]; par ^= 1;
        CvtBlk nxt = cvt_decode(A, F.ws, j0, j1, b < total ? b : 0); nxt.ok = nxt.ok && (b < total);
        if (nxt.ok) cvt_load(nxt, vb, F.tid);
        cvt_from_lds(cur, tile, F.tid);
        __syncthreads();
        cur = nxt;
#pragma unroll
        for (int i = 0; i < 16; ++i) va[i] = vb[i];
    }
    __syncthreads();
}
__device__ __forceinline__ void p0_prologue(Frame& F, const Args& A) {
    const int gw = F.vcu * NWAVES + F.wave, NGW = F.G * NWAVES;
    const int gtid = F.vcu * 512 + F.tid, NGT = F.G * 512;
    {
        LAS float* sil = (LAS float*)(F.lds + 69632);
        LAS float* red = (LAS float*)(F.lds + 86016);
        const float* c = A.in[1]; const float* cc = A.in[3]; const float* w_ada = A.in[4]; const float* b_ada = A.in[5];
        float* mods = (float*)(F.ws + WS_MODS);
        for (int i = F.tid; i < 2048; i += 512) { sil[i] = siluf_(c[i]); sil[2048 + i] = siluf_(cc[i]); }
        __syncthreads();
        for (int it = F.vcu; it < 2 * 72; it += F.G) {
            const int l = it / 72, nb = it % 72, n0 = nb * 256 + 4 * (F.tid & 63);
            f32x4 a0 = {0.f, 0.f, 0.f, 0.f}, a1 = {0.f, 0.f, 0.f, 0.f};
            const float* wp = w_ada + (size_t)l * 2048 * 18432 + n0;
#pragma unroll 8
            for (int k = F.wave; k < 2048; k += 8) { const f32x4 wv = *(const GAS f32x4*)(wp + (size_t)k * 18432); const float s0 = sil[k], s1 = sil[2048 + k]; a0 += wv * s0; a1 += wv * s1; }
            *(LAS f32x4*)(red + (F.wave * 2 + 0) * 256 + 4 * (F.tid & 63)) = a0; *(LAS f32x4*)(red + (F.wave * 2 + 1) * 256 + 4 * (F.tid & 63)) = a1;
            __syncthreads();
            { const int v = F.tid >> 8, col = F.tid & 255; float s = 0.f;
#pragma unroll
              for (int w = 0; w < 8; ++w) s += red[(w * 2 + v) * 256 + col];
              mods[(size_t)(l * 2 + v) * 18432 + nb * 256 + col] = s + b_ada[l * 18432 + nb * 256 + col]; }
            __syncthreads();
        }
    }
    { f32x2* tab = (f32x2*)(F.ws + WS_ROPE);
      for (int i = gtid; i < 128 * 32; i += NGT) { const int pos = i >> 5, pi = i & 31; const float ang = (float)pos * ROPE_INV[pi]; float c, s; sincos_d((double)ang, c, s); tab[i] = (f32x2){c, s}; } }
    { const GAS f32x4* x4 = (const GAS f32x4*)A.in[0]; const GAS f32x4* c4 = (const GAS f32x4*)A.in[2]; GAS f32x4* h4 = (GAS f32x4*)(F.ws + WS_H);
      for (int i = gtid; i < L * D / 4; i += NGT) h4[i] = x4[i];
      for (int i = gtid; i < LC * D / 4; i += NGT) h4[L * D / 4 + i] = c4[i]; }
    for (int it = gw; it < 2 * 4 * 32 * 32; it += NGW) {
        const int dblk = it & 31, c8 = (it >> 5) & 31, g = (it >> 10) & 3, l = it >> 12;
        const int d = dblk * 64 + (F.tid & 63);
        const float* pw = A.in[11] + ((size_t)(l * 4 + g) * 256 + c8 * 8) * 256;
        const float* sc = A.in[12] + l * 1024 + g * 256;
        const float* wpo = A.in[15] + ((size_t)l * 1024 + g * 256) * 2048 + d;
        float acc[8];
#pragma unroll
        for (int i = 0; i < 8; ++i) acc[i] = 0.f;
#pragma unroll 4
        for (int j = 0; j < 256; ++j) { const float t = sc[j] * wpo[(size_t)j * 2048];
#pragma unroll
            for (int i = 0; i < 8; ++i) acc[i] += pw[i * 256 + j] * t; }
        bf16* wt = (bf16*)(F.ws + WS_W + (size_t)l * W_LAYER + W_WMRG);
        v4u o; o.x = pk2(acc[0], acc[1]); o.y = pk2(acc[2], acc[3]); o.z = pk2(acc[4], acc[5]); o.w = pk2(acc[6], acc[7]);
        *(GAS v4u*)(wt + (size_t)d * KCAT + 2048 + g * 256 + c8 * 8) = o;
    }
    __syncthreads();
    convert_jobs(F, A, 0, 1, F.ctl + CW_Q + 0 * 64);
}

template <bool FINAL>
__device__ __forceinline__ void norm_phase(Frame& F, int l, const float* gnorm, int shift_idx, int scale_idx) {
    LAS float* TA = (LAS float*)(F.lds);
    LAS float* TB = TA + 4096;
    const float* mods = (const float*)(F.ws + WS_MODS);
    for (int i = F.tid; i < 4096; i += 512) { const int v = i >> 11, col = i & 2047; const float* mv = mods + (size_t)(l * 2 + v) * 18432;
        if (FINAL) { TA[i] = gnorm[col]; TB[i] = 0.f; } else { TA[i] = gnorm[col] * (1.0f + mv[scale_idx * 2048 + col]); TB[i] = mv[shift_idx * 2048 + col]; } }
    __syncthreads();
    const int gw = F.vcu * NWAVES + F.wave, NGW = F.G * NWAVES;
    const float* H = (const float*)(F.ws + WS_H); bf16* XN = (bf16*)(F.ws + WS_XN);
    const int nrows = FINAL ? L : MALL;
    for (int r = gw; r < nrows; r += NGW) {
        const int v = (r >= L) ? 1 : 0;
        const GAS f32x4* hr = (const GAS f32x4*)(H + (size_t)r * D) + (F.tid & 63);
        f32x4 x[8];
#pragma unroll
        for (int j = 0; j < 8; ++j) x[j] = hr[64 * j];
        float ss = 0.f;
#pragma unroll
        for (int j = 0; j < 8; ++j) ss += (x[j].x * x[j].x + x[j].y * x[j].y) + (x[j].z * x[j].z + x[j].w * x[j].w);
        const float rstd = 1.0f / sqrtf(wave_sum(ss, (F.tid & 63)) * (1.0f / D) + EPS);
        if (FINAL) { GAS f32x4* o = (GAS f32x4*)(F.out + (size_t)r * D) + (F.tid & 63);
#pragma unroll
            for (int j = 0; j < 8; ++j) { const f32x4 av = *(LAS f32x4*)(TA + 4 * (F.tid & 63) + 256 * j); o[64 * j] = x[j] * rstd * av; } }
        else { GAS v2u* o = (GAS v2u*)(XN + (size_t)r * D) + (F.tid & 63);
#pragma unroll
            for (int j = 0; j < 8; ++j) { const f32x4 av = *(LAS f32x4*)(TA + v * 2048 + 4 * (F.tid & 63) + 256 * j), bv = *(LAS f32x4*)(TB + v * 2048 + 4 * (F.tid & 63) + 256 * j);
                const f32x4 y = x[j] * rstd * av + bv; v2u w; w.x = pk2(y.x, y.y); w.y = pk2(y.z, y.w); o[64 * j] = w; } }
    }
    __syncthreads();
}

__device__ __forceinline__ void prep_phase(Frame& F, const float* conv_w) {
    const bf16* P = (const bf16*)(F.ws + WS_P); bf16* ACAT = (bf16*)(F.ws + WS_ACAT);
    const int gtid = F.vcu * 512 + F.tid, NGT = F.G * 512;
    for (int i = gtid; i < MALL * 128; i += NGT) { const int r = i >> 7, c = (i & 127) * 8, g = c >> 8, w = 2 << g;
        const int s0 = (r >= L) ? L : 0, sl = (r >= L) ? LC : L, tt0 = r - s0;
        int lo = tt0 - (w >> 1); lo = lo < 0 ? 0 : lo; int hi = tt0 + (w - (w >> 1)) - 1; hi = hi > sl - 1 ? sl - 1 : hi;
        float acc[8];
#pragma unroll
        for (int k = 0; k < 8; ++k) acc[k] = 0.f;
        for (int tt = lo; tt <= hi; ++tt) { const v4u u = *(const GAS v4u*)(P + (size_t)(s0 + tt) * NIN + POOL_OFF + c);
#pragma unroll
            for (int k = 0; k < 4; ++k) { acc[2 * k] += bflo(u[k]); acc[2 * k + 1] += bfhi(u[k]); } }
        const float inv = 1.0f / (float)(hi - lo + 1); const v4u u = *(const GAS v4u*)(P + (size_t)r * NIN + POOL_OFF + c); v4u o;
#pragma unroll
        for (int k = 0; k < 4; ++k) o[k] = pk2(acc[2 * k] * inv - bflo(u[k]), acc[2 * k + 1] * inv - bfhi(u[k]));
        *(GAS v4u*)(ACAT + (size_t)r * KCAT + 2048 + c) = o; }
    const float* cw = conv_w;
    for (int i = gtid; i < MALL * 128; i += NGT) { const int r = i >> 7, c = (i & 127) * 8;
        const int s0 = (r >= L) ? L : 0, sl = (r >= L) ? LC : L, tt0 = r - s0;
        float cx[3][8];
#pragma unroll
        for (int dt = 0; dt < 3; ++dt) { const int tt = tt0 + dt - 1;
            if (tt >= 0 && tt < sl) { const bf16* pr = P + (size_t)(s0 + tt) * NIN; const v4u cg = *(const GAS v4u*)(pr + CC_OFF + c), xv = *(const GAS v4u*)(pr + CX_OFF + c);
#pragma unroll
                for (int k = 0; k < 4; ++k) { cx[dt][2 * k] = bflo(cg[k]) * bflo(xv[k]); cx[dt][2 * k + 1] = bfhi(cg[k]) * bfhi(xv[k]); } }
            else {
#pragma unroll
                for (int k = 0; k < 8; ++k) cx[dt][k] = 0.f; } }
        const v4u bg = *(const GAS v4u*)(P + (size_t)r * NIN + CB_OFF + c); float y[8];
#pragma unroll
        for (int k = 0; k < 8; ++k) y[k] = cx[0][k] * cw[c + k] + cx[1][k] * cw[1024 + c + k] + cx[2][k] * cw[2048 + c + k];
        v4u o;
#pragma unroll
        for (int k = 0; k < 4; ++k) o[k] = pk2(bflo(bg[k]) * y[2 * k], bfhi(bg[k]) * y[2 * k + 1]);
        *(GAS v4u*)(ACAT + (size_t)r * KCAT + 3072 + c) = o; }
}

typedef short s16x8 __attribute__((ext_vector_type(8)));
typedef float f32x16 __attribute__((ext_vector_type(16)));
__device__ __forceinline__ f32x4 mini_tile(const bf16* A, int lda, const bf16* Bt, int ldb, int k0, int klen, int r0, int c0, LAS float* red, int tid) {
    const int wave = __builtin_amdgcn_readfirstlane(tid >> 6), lane = tid & 63, r32 = lane & 31, hi = lane >> 5;
    const int kw = klen >> 3, kb = k0 + wave * kw;
    const bf16* ap = A + (size_t)(r0 + r32) * lda + kb + 8 * hi; const bf16* b0p = Bt + (size_t)(c0 + r32) * ldb + kb + 8 * hi; const bf16* b1p = b0p + (size_t)32 * ldb;
    f32x16 acc0 = {}, acc1 = {};
#pragma unroll 4
    for (int k = 0; k < kw; k += 16) { const s16x8 a = *(const GAS s16x8*)(ap + k), b0 = *(const GAS s16x8*)(b0p + k), b1 = *(const GAS s16x8*)(b1p + k);
        acc0 = __builtin_amdgcn_mfma_f32_32x32x16_bf16(a, b0, acc0, 0, 0, 0); acc1 = __builtin_amdgcn_mfma_f32_32x32x16_bf16(a, b1, acc1, 0, 0, 0); }
#pragma unroll
    for (int r = 0; r < 16; ++r) { const int row = (r & 3) + 8 * (r >> 2) + 4 * hi; red[(wave * 32 + row) * 64 + r32] = acc0[r]; red[(wave * 32 + row) * 64 + 32 + r32] = acc1[r]; }
    __syncthreads();
    const int row = tid >> 4, c4 = (tid & 15) * 4; f32x4 s = {0.f, 0.f, 0.f, 0.f};
#pragma unroll
    for (int w = 0; w < 8; ++w) s += *(LAS f32x4*)(red + (w * 32 + row) * 64 + c4);
    __syncthreads();
    return s;
}
__device__ __forceinline__ void ctx_resid(Frame& F, const bf16* A, int lda, const bf16* Bt, int K, const float* gate, float gs) {
    float* H = (float*)(F.ws + WS_H);
    for (int mt = F.vcu; mt < 256; mt += F.G) { const int r0 = (mt >> 5) * 32, c0 = (mt & 31) * 64;
        const f32x4 v = mini_tile(A + (size_t)L * lda, lda, Bt, K, 0, K, r0, c0, (LAS float*)F.lds, F.tid);
        const int row = L + r0 + (F.tid >> 4), col = c0 + 4 * (F.tid & 15);
        f32x4* p = (f32x4*)(H + (size_t)row * D + col); *p = *p + *(const f32x4*)(gate + col) * gs * v; }
}
__device__ __forceinline__ void ctx_merge(Frame& F, const bf16* Bt) {
    const bf16* ACAT = (const bf16*)(F.ws + WS_ACAT); const bf16* P = (const bf16*)(F.ws + WS_P); bf16* MRG = (bf16*)(F.ws + WS_MRG);
    for (int mt = F.vcu; mt < 256; mt += F.G) { const int r0 = (mt >> 5) * 32, c0 = (mt & 31) * 64;
        const int row = L + r0 + (F.tid >> 4), col = c0 + 4 * (F.tid & 15); f32x4 s = {0.f, 0.f, 0.f, 0.f};
#pragma unroll
        for (int sg = 0; sg < 3; ++sg) { const int k0 = sg == 0 ? 0 : (sg == 1 ? 2048 : 3072), kl = sg == 0 ? 2048 : 1024;
            const f32x4 v = mini_tile(ACAT + (size_t)L * KCAT, KCAT, Bt, KCAT, k0, kl, r0, c0, (LAS float*)F.lds, F.tid);
            const v2u gw = *(const GAS v2u*)(P + (size_t)row * NIN + GATE_OFF + sg * D + col);
            s[0] += bflo(gw.x) * v[0]; s[1] += bfhi(gw.x) * v[1]; s[2] += bflo(gw.y) * v[2]; s[3] += bfhi(gw.y) * v[3]; }
        v2u w; w.x = pk2(s[0], s[1]); w.y = pk2(s[2], s[3]); *(GAS v2u*)(MRG + (size_t)row * D + col) = w; }
}

__device__ __forceinline__ void attn_phase(Frame& F, const float* sink, int nunits, char* lds) {
    const bf16* P = (const bf16*)(F.ws + WS_P); bf16* ACAT = (bf16*)(F.ws + WS_ACAT);
    for (int u = F.vcu; u < nunits; u += F.G) { const int hp = u & 1, kvh = (u >> 1) & 3, qb = u >> 3;
        att::attn_unit(P, NIN, Q_OFF, K_OFF, V_OFF, ACAT, KCAT, qb, kvh, kvh * 4 + hp * 2, sink, lds, F.tid); }
    __syncthreads();
}

__global__ void __launch_bounds__(NWAVES * 64, 2) fwd(Args args) {
    extern __shared__ __attribute__((aligned(16))) unsigned char lds[];
    Frame F;
    F.lds = (LAS unsigned char*)lds;
    F.MISC = (volatile LAS unsigned*)(F.lds + MISC_OFF);
    F.tid = threadIdx.x; F.wave = __builtin_amdgcn_readfirstlane(F.tid >> 6);
    F.G = gridDim.x; { const int bx = blockIdx.x; F.vcu = (F.G % 8 == 0) ? (bx % 8) * (F.G / 8) + bx / 8 : bx; }
    F.ws = args.ws; F.out = args.out; F.ctl = (gu32*)(args.ws + WS_CTL);
    for (int u = F.tid; u < (LDS_BYTES - LDSCTL_OFF) / 4; u += NWAVES * 64) ((LAS unsigned*)(F.lds + LDSCTL_OFF))[u] = 0u;
    __syncthreads();
    const int lo = args.ph_lo, hi = args.ph_hi;
    XcdBarrier bar; bar.bar = (unsigned*)(F.ctl + CW_BAR); bar.x = 0; bar.st = nullptr;
    if (hi - lo > 1) bar = xcd_barrier_post((unsigned*)(F.ctl + CW_BAR), F.MISC + 8, F.tid);
#define IN(k) (lo <= (k) && (k) < hi)
#define SEAM(k) do { if (IN(k) && IN((k) + 1)) xcd_barrier(bar, F.tid); } while (0)
    int bx = blockIdx.x;
#define LAUNDER() do { asm volatile("" : "+v"(F.tid)); asm volatile("" : "+s"(F.wave), "+s"(F.vcu), "+s"(F.G), "+s"(bx)); } while (0)
    bf16* XN = (bf16*)(F.ws + WS_XN); bf16* ACT = (bf16*)(F.ws + WS_ACT); bf16* P = (bf16*)(F.ws + WS_P); bf16* ACAT = (bf16*)(F.ws + WS_ACAT);
    bf16* MRG = (bf16*)(F.ws + WS_MRG); float* C = (float*)(F.ws + WS_C); float* Hs = (float*)(F.ws + WS_H);

    LAUNDER(); if (IN(0)) { p0_prologue(F, args); } SEAM(0);

    for (int l = 0; l < NLAYER; ++l) {
        const int pb = 1 + l * NPL; const bool lastl = (l == NLAYER - 1);
        unsigned char* wl = F.ws + WS_W + (size_t)l * W_LAYER;
        const float* ng = args.in[6] + (size_t)l * 3 * D;
        const float* mlat = (const float*)(F.ws + WS_MODS) + (size_t)(l * 2 + 0) * 18432; const float* mctx = mlat + 18432;
        LAUNDER(); if (IN(pb + 0)) norm_phase<false>(F, l, ng, 0, 1);
        SEAM(pb + 0);
        LAUNDER(); if (IN(pb + 1)) { pg8::Gemm g{XN, (const bf16*)(wl + W_WI1), D}; pg8::StaticOrder S; S.init(MALL, 2 * FF, D, F.G, bx); pg8::EpiSwiglu E{ACT, FF};
            pg8::gemm_phase<pg8::EpiSwiglu, pg8::StaticOrder, true, true>(F.lds + RING_OFF, g, S, E, F.tid);
            convert_jobs(F, args, 8 * l + 1, 8 * l + 3, F.ctl + CW_Q + (1 + 3 * l) * 64); }
        SEAM(pb + 1);
        LAUNDER(); if (IN(pb + 2)) { pg8::Gemm g{ACT, (const bf16*)(wl + W_WO1), FF}; pg8::StaticOrder S; S.init(L, D, FF, F.G, bx); pg8::EpiResid E{Hs, D, mlat + 2 * D, 0.5f};
            pg8::gemm_phase<pg8::EpiResid, pg8::StaticOrder, true, true>(F.lds + RING_OFF, g, S, E, F.tid);
            ctx_resid(F, ACT, FF, (const bf16*)(wl + W_WO1), FF, mctx + 2 * D, 0.5f); }
        SEAM(pb + 2);
        LAUNDER(); if (IN(pb + 3)) norm_phase<false>(F, l, ng + D, 3, 4);
        SEAM(pb + 3);
        LAUNDER(); if (IN(pb + 4)) { pg8::Gemm g{XN, (const bf16*)(wl + W_WIN), D}; pg8::StaticOrder S; S.init(MALL, NIN, D, F.G, bx); pg8::EpiIn E{P, NIN, (const float*)(F.ws + WS_ROPE), L, 10, 28};
            pg8::gemm_phase<pg8::EpiIn, pg8::StaticOrder, true, true>(F.lds + RING_OFF, g, S, E, F.tid);
            convert_jobs(F, args, 8 * l + 3, 8 * l + 7, F.ctl + CW_Q + (2 + 3 * l) * 64); }
        SEAM(pb + 4);
        LAUNDER(); if (IN(pb + 5)) { attn_phase(F, args.in[10] + l * NQH, lastl ? 512 : 528, (char*)lds + RING_OFF); prep_phase(F, args.in[13] + (size_t)l * 3 * 1024); }
        SEAM(pb + 5);
        LAUNDER(); if (IN(pb + 6)) { pg8::Gemm g{ACAT, (const bf16*)(wl + W_WMRG), KCAT}; pg8::SegOrder S; S.init(L, D, KCAT, F.G, bx); pg8::EpiMerge E{P, NIN, GATE_OFF, C, MRG, D};
            pg8::gemm_phase<pg8::EpiMerge, pg8::SegOrder, true, true>(F.lds + RING_OFF, g, S, E, F.tid);
            if (!lastl) ctx_merge(F, (const bf16*)(wl + W_WMRG)); }
        SEAM(pb + 6);
        LAUNDER(); if (IN(pb + 7)) { pg8::Gemm g{MRG, (const bf16*)(wl + W_WOUT), D}; pg8::StaticOrder S; S.init(L, D, D, F.G, bx); pg8::EpiResid E{Hs, D, mlat + 5 * D, 1.0f};
            pg8::gemm_phase<pg8::EpiResid, pg8::StaticOrder, true, true>(F.lds + RING_OFF, g, S, E, F.tid);
            if (!lastl) ctx_resid(F, MRG, D, (const bf16*)(wl + W_WOUT), D, mctx + 5 * D, 1.0f); }
        SEAM(pb + 7);
        LAUNDER(); if (IN(pb + 8)) norm_phase<false>(F, l, ng + 2 * D, 6, 7);
        SEAM(pb + 8);
        LAUNDER(); if (IN(pb + 9)) { pg8::Gemm g{XN, (const bf16*)(wl + W_WI2), D}; pg8::StaticOrder S; S.init(MALL, 2 * FF, D, F.G, bx); pg8::EpiSwiglu E{ACT, FF};
            pg8::gemm_phase<pg8::EpiSwiglu, pg8::StaticOrder, true, true>(F.lds + RING_OFF, g, S, E, F.tid);
            convert_jobs(F, args, 8 * l + 7, (8 * l + 9 < 16) ? 8 * l + 9 : 16, F.ctl + CW_Q + (3 + 3 * l) * 64); }
        SEAM(pb + 9);
        LAUNDER(); if (IN(pb + 10)) { pg8::Gemm g{ACT, (const bf16*)(wl + W_WO2), FF}; pg8::StaticOrder S; S.init(L, D, FF, F.G, bx); pg8::EpiResid E{Hs, D, mlat + 8 * D, 0.5f};
            pg8::gemm_phase<pg8::EpiResid, pg8::StaticOrder, true, true>(F.lds + RING_OFF, g, S, E, F.tid);
            if (!lastl) ctx_resid(F, ACT, FF, (const bf16*)(wl + W_WO2), FF, mctx + 8 * D, 0.5f); }
        SEAM(pb + 10);
    }
    LAUNDER(); if (IN(NPHASE - 1)) norm_phase<true>(F, NLAYER - 1, args.in[20], 0, 0);
#undef IN
#undef SEAM
#undef LAUNDER
}

extern "C" void kernel_launch(void* const* d_in, const int* in_sizes, int n_in, void* d_out, int out_size, void* d_ws, size_t ws_size, hipStream_t stream) {
    static int grid = 0;
    if (grid == 0) {
        if (n_in != 21 || in_sizes[0] != L * D || out_size != L * D || ws_size < WS_END) { fprintf(stderr, "kernel_launch: shape mismatch n_in %d in0 %d out %d ws %zu (need %zu)\n", n_in, n_in > 0 ? in_sizes[0] : -1, out_size, ws_size, (size_t)WS_END); grid = -1; return; }
        int dev = 0, cus = 0, per_cu = 0;
        if (hipGetDevice(&dev) != hipSuccess || hipDeviceGetAttribute(&cus, hipDeviceAttributeMultiprocessorCount, dev) != hipSuccess) { grid = -1; return; }
        if (hipFuncSetAttribute((const void*)fwd, hipFuncAttributeMaxDynamicSharedMemorySize, LDS_BYTES) != hipSuccess) { fprintf(stderr, "kernel_launch: hipFuncSetAttribute failed\n"); grid = -1; return; }
        if (hipOccupancyMaxActiveBlocksPerMultiprocessor(&per_cu, (const void*)fwd, NWAVES * 64, LDS_BYTES) != hipSuccess || per_cu < 1) fprintf(stderr, "kernel_launch: occupancy query says %d\n", per_cu);
        (void)hipGetLastError();
        grid = cus;
    }
    if (grid < 0) return;
    (void)hipMemsetAsync((char*)d_ws + WS_CTL, 0, CTL_ZERO_BYTES, stream);
    Args a{};
    for (int i = 0; i < 21; ++i) a.in[i] = (const float*)d_in[i];
    a.out = (float*)d_out; a.ws = (unsigned char*)d_ws;
#if defined(MK_PER_PHASE)
    for (int ph = 0; ph < NPHASE; ++ph) { a.ph_lo = ph; a.ph_hi = ph + 1; hipLaunchKernelGGL(fwd, dim3(grid), dim3(NWAVES * 64), LDS_BYTES, stream, a); }
#else
    a.ph_lo = 0; a.ph_hi = NPHASE; hipLaunchKernelGGL(fwd, dim3(grid), dim3(NWAVES * 64), LDS_BYTES, stream, a);
#endif
    const hipError_t le = hipPeekAtLastError();
    if (le != hipSuccess) fprintf(stderr, "kernel_launch: launch failed: %s\n", hipGetErrorName(le));
}
```

```cpp
#include <hip/hip_runtime.h>
#include <cstdio>
#include <cstdint>
namespace pg8 {
#define PG8_LAS __attribute__((address_space(3)))
typedef unsigned short bf16_t;
typedef short bf16x8 __attribute__((ext_vector_type(8)));
typedef float f32x4 __attribute__((ext_vector_type(4)));
typedef unsigned u32x4 __attribute__((ext_vector_type(4)));
constexpr int BM = 256, BK = 64, HALF = 128, HTB = HALF * BK * 2  , STAGE_BYTES = 8 * HTB, NXCD = 8, WGM = 8;

__host__ __device__ __forceinline__ int lds_byte(int r, int c) { const int st = (r >> 4) * 2 + (c >> 5), rr = r & 15, cc = c & 31, ob = rr * 64 + cc * 2; return st * 1024 + (ob ^ (((ob >> 9) & 1) << 5)); }
__host__ __device__ __forceinline__ void stage_rc(int b, int& R, int& C) { const int st = b / 1024, sb = b % 1024, swz = sb ^ (((sb >> 9) & 1) << 5); R = (st >> 1) * 16 + swz / 64; C = (st & 1) * 32 + (swz % 64) / 2; }
__host__ __device__ __forceinline__ int perm32(int rho) { const int n = rho >> 4, i = rho & 15; return 8 * (i >> 2) + 4 * n + (i & 3); }

struct Unit { int pm, pn, seg; };
struct Gemm { const bf16_t* A; const bf16_t* Bt; int K; };

struct StaticOrder {
    int nM, nN, nwg, G, c, ntk;
    __host__ __device__ void init(int M, int N, int K, int G_, int c_) { nM = M / BM; nN = N / BM; nwg = nM * nN; G = G_; c = c_; ntk = K / BK; }
    __device__ __forceinline__ int koff(const Unit&) const { return 0; }
    __device__ __forceinline__ int nt(const Unit&) const { return ntk; }
    __host__ __device__ bool next(int i, Unit& u) const {
        const long L = (long)i * G + c; if (L >= nwg) return false;
        int wgid = (int)L; { const int q = nwg / NXCD, r = nwg % NXCD, xcd = wgid % NXCD, off = wgid / NXCD; wgid = (xcd < r ? xcd * (q + 1) : r * (q + 1) + (xcd - r) * q) + off; }
        const int nig = WGM * nN, gid = wgid / nig, fm = gid * WGM, gsz = (nM - fm) < WGM ? (nM - fm) : WGM;
        u.pm = fm + ((wgid % nig) % gsz); u.pn = (wgid % nig) / gsz; u.seg = 0; return true;
    }
    __device__ __forceinline__ void a_ready(const Unit&) const {}
    __device__ __forceinline__ void done(const Unit&) const {}
};


__device__ __forceinline__ unsigned cvt_pk_bf16(float lo, float hi) { unsigned r; asm volatile("v_cvt_pk_bf16_f32 %0, %1, %2" : "=v"(r) : "v"(lo), "v"(hi)); return r; }

struct EpiF32 {
    static constexpr bool PERM = false, AFTER_DRAIN = false;
    float* C; int ldc;
    __device__ __forceinline__ void operator()(const f32x4 (&acc)[2][2][4][2], const Unit& u, int wr, int wc, int fr, int fq) const {
        const int row0 = u.pm * BM + wr * 64 + fr, col0 = u.pn * BM + wc * 32 + 4 * fq;
#pragma unroll
        for (int ai = 0; ai < 2; ++ai)
#pragma unroll
            for (int m = 0; m < 4; ++m) { float* rowp = C + (size_t)(row0 + ai * HALF + m * 16) * ldc + col0;
#pragma unroll
                for (int bj = 0; bj < 2; ++bj)
#pragma unroll
                    for (int n = 0; n < 2; ++n) *(f32x4*)(rowp + bj * HALF + n * 16) = acc[ai][bj][m][n]; }
    }
};
struct EpiBf16 {
    static constexpr bool PERM = true, AFTER_DRAIN = false;
    bf16_t* O; int ldc; size_t seg_stride;
    __device__ __forceinline__ void operator()(const f32x4 (&acc)[2][2][4][2], const Unit& u, int wr, int wc, int fr, int fq) const {
        const int row0 = u.pm * BM + wr * 64 + fr, col0 = u.pn * BM + wc * 32 + 8 * fq; bf16_t* base = O + (size_t)u.seg * seg_stride;
#pragma unroll
        for (int ai = 0; ai < 2; ++ai)
#pragma unroll
            for (int m = 0; m < 4; ++m) { bf16_t* rowp = base + (size_t)(row0 + ai * HALF + m * 16) * ldc + col0;
#pragma unroll
                for (int bj = 0; bj < 2; ++bj) { const f32x4 v0 = acc[ai][bj][m][0], v1 = acc[ai][bj][m][1];
                    u32x4 w; w.x = cvt_pk_bf16(v0[0], v0[1]); w.y = cvt_pk_bf16(v0[2], v0[3]); w.z = cvt_pk_bf16(v1[0], v1[1]); w.w = cvt_pk_bf16(v1[2], v1[3]);
                    *(u32x4*)(rowp + bj * HALF) = w; } }
    }
};

__device__ __forceinline__ float fast_sigmoid(float x) { return __builtin_amdgcn_rcpf(1.0f + __builtin_amdgcn_exp2f(-1.4426950408889634f * x)); }
struct EpiSwiglu {
    static constexpr bool PERM = true, AFTER_DRAIN = false;
    bf16_t* O; int ldc;
    __device__ __forceinline__ void operator()(const f32x4 (&acc)[2][2][4][2], const Unit& u, int wr, int wc, int fr, int fq) const {
        const int row0 = u.pm * BM + wr * 64 + fr, col0 = u.pn * HALF + wc * 32 + 8 * fq;
#pragma unroll
        for (int ai = 0; ai < 2; ++ai)
#pragma unroll
            for (int m = 0; m < 4; ++m) { bf16_t* rowp = O + (size_t)(row0 + ai * HALF + m * 16) * ldc + col0; f32x4 y[2];
#pragma unroll
                for (int n = 0; n < 2; ++n) { const f32x4 g = acc[ai][0][m][n], uu = acc[ai][1][m][n];
#pragma unroll
                    for (int i = 0; i < 4; ++i) y[n][i] = g[i] * fast_sigmoid(g[i]) * uu[i]; }
                u32x4 w; w.x = cvt_pk_bf16(y[0][0], y[0][1]); w.y = cvt_pk_bf16(y[0][2], y[0][3]); w.z = cvt_pk_bf16(y[1][0], y[1][1]); w.w = cvt_pk_bf16(y[1][2], y[1][3]);
                *(u32x4*)rowp = w; }
    }
};
struct EpiResid {
    static constexpr bool PERM = false, AFTER_DRAIN = false;
    float* H; int ldc; const float* gate; float gs;
    __device__ __forceinline__ void operator()(const f32x4 (&acc)[2][2][4][2], const Unit& u, int wr, int wc, int fr, int fq) const {
        const int row0 = u.pm * BM + wr * 64 + fr, col0 = u.pn * BM + wc * 32 + 4 * fq;
        f32x4 gv[2][2];
#pragma unroll
        for (int bj = 0; bj < 2; ++bj)
#pragma unroll
            for (int n = 0; n < 2; ++n) gv[bj][n] = *(const f32x4*)(gate + col0 + bj * HALF + n * 16) * gs;
#pragma unroll
        for (int ai = 0; ai < 2; ++ai)
#pragma unroll
            for (int m = 0; m < 4; ++m) { float* rowp = H + (size_t)(row0 + ai * HALF + m * 16) * ldc + col0;
#pragma unroll
                for (int bj = 0; bj < 2; ++bj)
#pragma unroll
                    for (int n = 0; n < 2; ++n) { f32x4* p = (f32x4*)(rowp + bj * HALF + n * 16); *p = *p + gv[bj][n] * acc[ai][bj][m][n]; }
                asm volatile("" ::: "memory"); }
    }
};
struct EpiIn {
    static constexpr bool PERM = true, AFTER_DRAIN = false;
    bf16_t* O; int ldc; const float* tab; int rope_rows, rope_tiles, gate_tile0;
    __device__ __forceinline__ void operator()(const f32x4 (&acc)[2][2][4][2], const Unit& u, int wr, int wc, int fr, int fq) const {
        const int row0 = u.pm * BM + wr * 64 + fr, col0 = u.pn * BM + wc * 32 + 8 * fq;
        const int mode = (u.pn < rope_tiles && u.pm * BM < rope_rows) ? 1 : (u.pn >= gate_tile0 ? 2 : 0);
        const int axis = wc >> 1, pi0 = 16 * (wc & 1) + 4 * fq;
#pragma unroll
        for (int ai = 0; ai < 2; ++ai)
#pragma unroll
            for (int m = 0; m < 4; ++m) { const int r = row0 + ai * HALF + m * 16; bf16_t* rowp = O + (size_t)r * ldc + col0;
                f32x4 cs0 = {1.f, 0.f, 1.f, 0.f}, cs1 = {1.f, 0.f, 1.f, 0.f};
                if (mode == 1) { const int pos = axis ? (r & 63) : (r >> 6); const float* tp = tab + (size_t)(pos * 32 + pi0) * 2; cs0 = *(const f32x4*)tp; cs1 = *(const f32x4*)(tp + 4); }
#pragma unroll
                for (int bj = 0; bj < 2; ++bj) { f32x4 v0 = acc[ai][bj][m][0], v1 = acc[ai][bj][m][1];
                    if (mode == 1) { const f32x4 t1 = v0, t2 = v1;
                        v0[0] = t1[0] * cs0[0] - t2[0] * cs0[1]; v1[0] = t2[0] * cs0[0] + t1[0] * cs0[1];
                        v0[1] = t1[1] * cs0[2] - t2[1] * cs0[3]; v1[1] = t2[1] * cs0[2] + t1[1] * cs0[3];
                        v0[2] = t1[2] * cs1[0] - t2[2] * cs1[1]; v1[2] = t2[2] * cs1[0] + t1[2] * cs1[1];
                        v0[3] = t1[3] * cs1[2] - t2[3] * cs1[3]; v1[3] = t2[3] * cs1[2] + t1[3] * cs1[3]; }
                    else if (mode == 2) {
#pragma unroll
                        for (int i = 0; i < 4; ++i) { v0[i] = fast_sigmoid(v0[i]); v1[i] = fast_sigmoid(v1[i]); } }
                    u32x4 w; w.x = cvt_pk_bf16(v0[0], v0[1]); w.y = cvt_pk_bf16(v0[2], v0[3]); w.z = cvt_pk_bf16(v1[0], v1[1]); w.w = cvt_pk_bf16(v1[2], v1[3]);
                    *(u32x4*)(rowp + bj * HALF) = w; } }
    }
};
struct EpiMerge {
    static constexpr bool PERM = true, AFTER_DRAIN = false;
    const bf16_t* G; int ldg; int gate_off; float* S; bf16_t* O; int ldc;
    __device__ __forceinline__ void operator()(const f32x4 (&acc)[2][2][4][2], const Unit& u, int wr, int wc, int fr, int fq) const {
        const int row0 = u.pm * BM + wr * 64 + fr, col0 = u.pn * BM + wc * 32 + 8 * fq; const int seg = u.seg;
#pragma unroll
        for (int ai = 0; ai < 2; ++ai)
#pragma unroll
            for (int m = 0; m < 4; ++m) { const int r = row0 + ai * HALF + m * 16;
#pragma unroll
                for (int bj = 0; bj < 2; ++bj) { const int c = col0 + bj * HALF;
                    const u32x4 gw = *(const u32x4*)(G + (size_t)r * ldg + gate_off + seg * ldc + c);
                    f32x4 g0, g1; g0[0] = __builtin_bit_cast(float, gw.x << 16); g0[1] = __builtin_bit_cast(float, gw.x & 0xffff0000u); g0[2] = __builtin_bit_cast(float, gw.y << 16); g0[3] = __builtin_bit_cast(float, gw.y & 0xffff0000u);
                    g1[0] = __builtin_bit_cast(float, gw.z << 16); g1[1] = __builtin_bit_cast(float, gw.z & 0xffff0000u); g1[2] = __builtin_bit_cast(float, gw.w << 16); g1[3] = __builtin_bit_cast(float, gw.w & 0xffff0000u);
                    f32x4 v0 = acc[ai][bj][m][0] * g0, v1 = acc[ai][bj][m][1] * g1; float* sp = S + (size_t)r * ldc + c;
                    if (seg > 0) { v0 += *(const f32x4*)sp; v1 += *(const f32x4*)(sp + 4); }
                    if (seg < 2) { *(f32x4*)sp = v0; *(f32x4*)(sp + 4) = v1; }
                    else { u32x4 w; w.x = cvt_pk_bf16(v0[0], v0[1]); w.y = cvt_pk_bf16(v0[2], v0[3]); w.z = cvt_pk_bf16(v1[0], v1[1]); w.w = cvt_pk_bf16(v1[2], v1[3]); *(u32x4*)(O + (size_t)r * ldc + c) = w; } }
                asm volatile("" ::: "memory"); }
    }
};
struct SegOrder : StaticOrder {
    __device__ __forceinline__ bool next(int i, Unit& u) const { const int t = i / 3; if (!StaticOrder::next(t, u)) return false; u.seg = i - 3 * t; return true; }
    __device__ __forceinline__ int koff(const Unit& u) const { return u.seg == 0 ? 0 : (u.seg == 1 ? 2048 : 3072); }
    __device__ __forceinline__ int nt(const Unit& u) const { return u.seg == 0 ? 32 : 16; }
};

template <class Epi, class Sched, bool ALIGN_EPI = false, bool SP2 = false>
__device__ __forceinline__ void gemm_phase(PG8_LAS unsigned char* lds, const Gemm g, const Sched& S, const Epi& E, int tid_in) {
    int tid_ = tid_in; asm volatile("" : "+v"(tid_));
    const int tid = tid_, wid = __builtin_amdgcn_readfirstlane(tid >> 6), lane = tid & 63, wr = wid >> 2, wc = wid & 3, fr = lane & 15, fq = lane >> 4;
    int K_ = g.K; asm volatile("" : "+s"(K_)); const int K = K_; int nt;
    unsigned voffA[2], voffB[2];
#pragma unroll
    for (int i = 0; i < 2; ++i) { int R, C; stage_rc(tid * 16 + i * 8192, R, C); const int Rb = Epi::PERM ? ((R & ~31) + perm32(R & 31)) : R;
        voffA[i] = (unsigned)(R * K + C) * 2u; voffB[i] = (unsigned)(Rb * K + C) * 2u; }
    const size_t kstep = (size_t)(BK * 2);
    const size_t hstep = (size_t)HALF * K * 2;
    const size_t tstep = 2 * hstep;
    const unsigned ldsw = (unsigned)wid * 1024u;
    const int aoff = lds_byte(wr * 64 + fr, fq * 8), boff = lds_byte(wc * 32 + fr, fq * 8);
#define PG8_SA(b, h) (((b) * 2 + (h)) * HTB)
#define PG8_SB(b, h) ((4 + (b) * 2 + (h)) * HTB)
#define PG8_STAGE(bufoff, gbase, voff) do { _Pragma("unroll") for (int _i = 0; _i < 2; ++_i) \
        __builtin_amdgcn_global_load_lds((const unsigned*)((const char*)(gbase) + (voff)[_i]), (PG8_LAS unsigned*)(lds + (bufoff) + ldsw + _i * 8192), 16, 0, 0); } while (0)
#define PG8_LDA(dst, b, h) do { _Pragma("unroll") for (int m = 0; m < 4; ++m) _Pragma("unroll") for (int k = 0; k < 2; ++k) dst[m][k] = *(const PG8_LAS bf16x8*)(lds + PG8_SA(b, h) + aoff + m * 2048 + k * 1024); } while (0)
#define PG8_LDB(dst, b, h) do { _Pragma("unroll") for (int n = 0; n < 2; ++n) _Pragma("unroll") for (int k = 0; k < 2; ++k) dst[n][k] = *(const PG8_LAS bf16x8*)(lds + PG8_SB(b, h) + boff + n * 2048 + k * 1024); } while (0)
#define PG8_MMA(ai, bj, At, Bt) do { __builtin_amdgcn_s_setprio(1); _Pragma("unroll") for (int m = 0; m < 4; ++m) _Pragma("unroll") for (int n = 0; n < 2; ++n) _Pragma("unroll") for (int k = 0; k < 2; ++k) \
        acc[ai][bj][m][n] = __builtin_amdgcn_mfma_f32_16x16x32_bf16(Bt[n][k], At[m][k], acc[ai][bj][m][n], 0, 0, 0); __builtin_amdgcn_s_setprio(0); } while (0)
#define PG8_WAIT_V(n) asm volatile("s_waitcnt vmcnt(" #n ")" ::: "memory")
#define PG8_WAIT_L(n) asm volatile("s_waitcnt lgkmcnt(" #n ")" ::: "memory")
#define PG8_BAR __builtin_amdgcn_s_barrier()
#define PG8_SCHED __builtin_amdgcn_sched_barrier(0)
    Unit cur, nxt; int ui = 0;
    if (!S.next(0, cur)) return;
    f32x4 acc[2][2][4][2];
#pragma unroll
    for (int a = 0; a < 2; ++a)
#pragma unroll
        for (int b = 0; b < 2; ++b)
#pragma unroll
            for (int m = 0; m < 4; ++m)
#pragma unroll
                for (int n = 0; n < 2; ++n) acc[a][b][m][n] = (f32x4){0.f, 0.f, 0.f, 0.f};
    bf16x8 At[4][2], B0[2][2], B1[2][2];
    const char* cA = (const char*)g.A + (size_t)cur.pm * tstep + (size_t)S.koff(cur) * 2; const char* cB = (const char*)g.Bt + (size_t)cur.pn * tstep + (size_t)S.koff(cur) * 2; nt = S.nt(cur);
    S.a_ready(cur);
    if constexpr (SP2) {
        PG8_STAGE(PG8_SB(0, 0), cB, voffB); PG8_STAGE(PG8_SB(0, 1), cB + hstep, voffB); PG8_STAGE(PG8_SA(0, 0), cA, voffA); PG8_STAGE(PG8_SA(0, 1), cA + hstep, voffA);
        if (wr == 1) PG8_BAR;
        PG8_WAIT_V(2); PG8_BAR;
        PG8_STAGE(PG8_SB(1, 0), cB + kstep, voffB); PG8_STAGE(PG8_SA(1, 0), cA + kstep, voffA); PG8_STAGE(PG8_SB(1, 1), cB + hstep + kstep, voffB);
        PG8_WAIT_V(6); PG8_BAR;
    } else {
        PG8_STAGE(PG8_SB(0, 0), cB, voffB); PG8_STAGE(PG8_SA(0, 0), cA, voffA); PG8_STAGE(PG8_SB(0, 1), cB + hstep, voffB); PG8_STAGE(PG8_SA(0, 1), cA + hstep, voffA);
        if (wr == 1) PG8_BAR;
        PG8_WAIT_V(4); PG8_BAR;
        PG8_STAGE(PG8_SB(1, 0), cB + kstep, voffB); PG8_STAGE(PG8_SA(1, 0), cA + kstep, voffA); PG8_STAGE(PG8_SB(1, 1), cB + hstep + kstep, voffB);
        PG8_WAIT_V(6); PG8_BAR;
    }
    for (;;) {
        const bool has_next = S.next(ui + 1, nxt);
        const char* nA = has_next ? (const char*)g.A + (size_t)nxt.pm * tstep + (size_t)S.koff(nxt) * 2 : cA; const char* nB = has_next ? (const char*)g.Bt + (size_t)nxt.pn * tstep + (size_t)S.koff(nxt) * 2 : cB;
        for (int t = 0; t < nt; t += 2) {
            const bool last = (t == nt - 2);
            const char* a1 = cA + (size_t)(t + 1) * kstep;
            const char* a2 = last ? nA : cA + (size_t)(t + 2) * kstep; const char* b2 = last ? nB : cB + (size_t)(t + 2) * kstep;
            const char* a3 = a2 + kstep; const char* b3 = b2 + kstep;
            if (last && has_next) S.a_ready(nxt);
            if constexpr (SP2) {
            PG8_LDB(B0, 0, 0); PG8_LDB(B1, 0, 1); PG8_SCHED; PG8_LDA(At, 0, 0); PG8_STAGE(PG8_SA(1, 1), a1 + hstep, voffA);
            PG8_WAIT_V(8); PG8_WAIT_L(0); PG8_BAR; PG8_MMA(0, 0, At, B0); PG8_MMA(0, 1, At, B1); PG8_BAR; PG8_SCHED;
            PG8_LDA(At, 0, 1); PG8_STAGE(PG8_SB(0, 0), b2, voffB); PG8_STAGE(PG8_SB(0, 1), b2 + hstep, voffB); PG8_STAGE(PG8_SA(0, 0), a2, voffA);
            PG8_WAIT_V(8); PG8_WAIT_L(0); PG8_BAR; PG8_MMA(1, 0, At, B0); PG8_MMA(1, 1, At, B1); PG8_BAR; PG8_SCHED;
            PG8_LDB(B0, 1, 0); PG8_LDB(B1, 1, 1); PG8_SCHED; PG8_LDA(At, 1, 0); PG8_STAGE(PG8_SA(0, 1), a2 + hstep, voffA);
            PG8_WAIT_V(8); PG8_WAIT_L(0); PG8_BAR; PG8_MMA(0, 0, At, B0); PG8_MMA(0, 1, At, B1); PG8_BAR; PG8_SCHED;
            PG8_LDA(At, 1, 1); PG8_STAGE(PG8_SB(1, 0), b3, voffB); PG8_STAGE(PG8_SB(1, 1), b3 + hstep, voffB); PG8_STAGE(PG8_SA(1, 0), a3, voffA);
            PG8_WAIT_V(8); PG8_WAIT_L(0); PG8_BAR; PG8_MMA(1, 0, At, B0); PG8_MMA(1, 1, At, B1); PG8_BAR; PG8_SCHED;
            } else {
            PG8_LDB(B0, 0, 0); PG8_SCHED; PG8_LDA(At, 0, 0); PG8_STAGE(PG8_SA(1, 1), a1 + hstep, voffA);
            PG8_WAIT_L(8); PG8_BAR; PG8_WAIT_L(0); PG8_MMA(0, 0, At, B0); PG8_BAR; PG8_SCHED;
            PG8_LDB(B1, 0, 1); PG8_STAGE(PG8_SB(0, 0), b2, voffB);
            PG8_BAR; PG8_WAIT_L(0); PG8_MMA(0, 1, At, B1); PG8_BAR;
            PG8_LDA(At, 0, 1); PG8_STAGE(PG8_SA(0, 0), a2, voffA);
            PG8_BAR; PG8_WAIT_L(0); PG8_MMA(1, 0, At, B0); PG8_BAR; PG8_SCHED;
            PG8_STAGE(PG8_SB(0, 1), b2 + hstep, voffB);
            PG8_WAIT_V(6); PG8_BAR; PG8_MMA(1, 1, At, B1); PG8_BAR;
            PG8_LDB(B0, 1, 0); PG8_SCHED; PG8_LDA(At, 1, 0); PG8_STAGE(PG8_SA(0, 1), a2 + hstep, voffA);
            PG8_WAIT_L(8); PG8_BAR; PG8_WAIT_L(0); PG8_MMA(0, 0, At, B0); PG8_BAR; PG8_SCHED;
            PG8_LDB(B1, 1, 1); PG8_STAGE(PG8_SB(1, 0), b3, voffB);
            PG8_BAR; PG8_WAIT_L(0); PG8_MMA(0, 1, At, B1); PG8_BAR;
            PG8_LDA(At, 1, 1); PG8_STAGE(PG8_SA(1, 0), a3, voffA);
            PG8_BAR; PG8_WAIT_L(0); PG8_MMA(1, 0, At, B0); PG8_BAR; PG8_SCHED;
            PG8_STAGE(PG8_SB(1, 1), b3 + hstep, voffB);
            PG8_WAIT_V(6); PG8_BAR; PG8_MMA(1, 1, At, B1); PG8_BAR;
            }
        }
        if constexpr (ALIGN_EPI) { if (wr == 0) PG8_BAR; }
        if constexpr (!Epi::AFTER_DRAIN) { E(acc, cur, wr, wc, fr, fq); S.done(cur); }
        if (!has_next) break;
#pragma unroll
        for (int a = 0; a < 2; ++a)
#pragma unroll
            for (int b = 0; b < 2; ++b)
#pragma unroll
                for (int m = 0; m < 4; ++m)
#pragma unroll
                    for (int n = 0; n < 2; ++n) acc[a][b][m][n] = (f32x4){0.f, 0.f, 0.f, 0.f};
        cur = nxt; cA = nA; cB = nB; ++ui; nt = S.nt(cur);
        if constexpr (ALIGN_EPI) { if (wr == 1) PG8_BAR; }
    }
    PG8_WAIT_V(0);
    if constexpr (!ALIGN_EPI) { if (wr == 0) PG8_BAR; }
    PG8_BAR;
    if constexpr (Epi::AFTER_DRAIN) { E.fused(acc, cur, wr, wc, fr, fq, lds, wid, lane); S.done(cur); }
#undef PG8_SA
#undef PG8_SB
#undef PG8_STAGE
#undef PG8_LDA
#undef PG8_LDB
#undef PG8_MMA
#undef PG8_WAIT_V
#undef PG8_WAIT_L
#undef PG8_BAR
#undef PG8_SCHED
}
}


namespace att {
typedef unsigned short bf16;
constexpr int D = 128, NW = 8, QBLK = 32, KVBLK = 64;
constexpr float SCALE = 0.088388347648318440f;
constexpr float THR = 8.f;
constexpr int SDEPTH = 1;
constexpr size_t SHM_V = KVBLK * D * 2, SHM_K = KVBLK * D * 2, SHM_ATTN = 2 * SHM_V + 2 * SHM_K + NW * 64 * 4;
using bf16x8 = __attribute__((ext_vector_type(8))) short;
using s16x4  = __attribute__((ext_vector_type(4))) short;
using f32x16 = __attribute__((ext_vector_type(16))) float;
using u32x4  = __attribute__((ext_vector_type(4))) unsigned;
#define KSWZ(row, colB) ((row) * 256 + ((colB) ^ (((row) & 7) << 4)))
#define SBAR() __builtin_amdgcn_sched_barrier(0)
__device__ __forceinline__ int crow(int r, int hi) { return (r & 3) + 8 * (r >> 2) + 4 * hi; }
__device__ __forceinline__ unsigned cvtpk(float lo, float hi) {
  unsigned r; asm volatile("v_cvt_pk_bf16_f32 %0, %1, %2" : "=v"(r) : "v"(lo), "v"(hi)); return r;
}
__device__ __forceinline__ void partialSM(f32x16& p0, f32x16& p1, float& m_reg, float& mn, float& alpha) {
  constexpr float C = SCALE * 1.4426950408889634f;
  float pmax = p0[0]; for (int r = 1; r < 16; ++r) pmax = fmaxf(pmax, p0[r]); for (int r = 0; r < 16; ++r) pmax = fmaxf(pmax, p1[r]);
  { auto rr = __builtin_amdgcn_permlane32_swap(__float_as_uint(pmax), __float_as_uint(pmax), false, false);
    pmax = fmaxf(__uint_as_float(rr[0]), __uint_as_float(rr[1])); }
  if (__builtin_expect(__all(pmax - m_reg <= THR / SCALE), 1)) { mn = m_reg; alpha = 1.f; }
  else { mn = fmaxf(m_reg, pmax); alpha = __builtin_amdgcn_exp2f((m_reg - mn) * C); m_reg = mn; }
  float mnC = -mn * C;
  for (int r = 0; r < 16; ++r) p0[r] = fmaf(p0[r], C, mnC); for (int r = 0; r < 16; ++r) p1[r] = fmaf(p1[r], C, mnC);
  for (int r = 0; r < 16; ++r) p0[r] = __builtin_amdgcn_exp2f(p0[r]);
}
__device__ __forceinline__ void finishSM(f32x16& p0, f32x16& p1, float alpha, float& l_reg, bf16x8& pa0, bf16x8& pa1, bf16x8& pa2, bf16x8& pa3) {
  for (int r = 0; r < 16; ++r) p1[r] = __builtin_amdgcn_exp2f(p1[r]);
  float ps = 0; for (int r = 0; r < 16; ++r) ps += p0[r]; for (int r = 0; r < 16; ++r) ps += p1[r];
  { auto rr = __builtin_amdgcn_permlane32_swap(__float_as_uint(ps), __float_as_uint(ps), false, false);
    ps = __uint_as_float(rr[0]) + __uint_as_float(rr[1]); }
  l_reg = l_reg * alpha + ps;
#define PK4(P, BASE, OUT) do { unsigned a0 = cvtpk(P[BASE + 0], P[BASE + 1]), a1 = cvtpk(P[BASE + 2], P[BASE + 3]);   \
    unsigned b0 = cvtpk(P[BASE + 4], P[BASE + 5]), b1 = cvtpk(P[BASE + 6], P[BASE + 7]);                              \
    auto r0 = __builtin_amdgcn_permlane32_swap(a0, b0, false, false); auto r1 = __builtin_amdgcn_permlane32_swap(a1, b1, false, false); \
    u32x4 w = {r0[0], r1[0], r0[1], r1[1]}; OUT = *reinterpret_cast<bf16x8*>(&w); } while (0)
  PK4(p0, 0, pa0); PK4(p0, 8, pa1); PK4(p1, 0, pa2); PK4(p1, 8, pa3);
#undef PK4
}
__device__ __forceinline__ void qkt(f32x16& p0, f32x16& p1, const bf16* Ks, const bf16x8* qr, int r32, int hi) {
  p0 = f32x16{}; p1 = f32x16{};
  for (int d0 = 0; d0 < 8; ++d0) { int cb = (d0 * 16 + hi * 8) * 2;
    bf16x8 b0 = *reinterpret_cast<const bf16x8*>((const char*)Ks + KSWZ(r32, cb));
    bf16x8 b1 = *reinterpret_cast<const bf16x8*>((const char*)Ks + KSWZ(32 + r32, cb));
    p0 = __builtin_amdgcn_mfma_f32_32x32x16_bf16(b0, qr[d0], p0, 0, 0, 0);
    p1 = __builtin_amdgcn_mfma_f32_32x32x16_bf16(b1, qr[d0], p1, 0, 0, 0); }
}
__device__ __forceinline__ int v_st(int k, int c) { const int kk = (k & ~0xC) | ((k & 4) << 1) | ((k & 8) >> 1); return ((kk >> 3) * 4 + (c >> 5)) * 512 + ((kk & 7) * 32 + (c & 31)) * 2; }
__device__ __forceinline__ int v_rd_base(int lane) { return ((lane & 3) << 3) | (((lane >> 2) & 3) << 6) | (((lane >> 4) & 1) << 5) | (((lane >> 5) & 1) << 8); }
constexpr int v_rd_off(int d0, int ks, int half) { return d0 * 512 + ks * 4096 + half * 2048; }
template <int OFF> __device__ __forceinline__ s16x4 tr_read(int vb) {
  s16x4 r; asm volatile("ds_read_b64_tr_b16 %0, %1 offset:%2" : "=&v"(r) : "v"(vb), "i"(OFF) : "memory"); return r;
}
template <int D0> __device__ __forceinline__ void pv_one(f32x16& od, int vb, bf16x8 pa0, bf16x8 pa1, bf16x8 pa2, bf16x8 pa3) {
  const s16x4 l0 = tr_read<v_rd_off(D0, 0, 0)>(vb), h0 = tr_read<v_rd_off(D0, 0, 1)>(vb), l1 = tr_read<v_rd_off(D0, 1, 0)>(vb), h1 = tr_read<v_rd_off(D0, 1, 1)>(vb);
  const s16x4 l2 = tr_read<v_rd_off(D0, 2, 0)>(vb), h2 = tr_read<v_rd_off(D0, 2, 1)>(vb), l3 = tr_read<v_rd_off(D0, 3, 0)>(vb), h3 = tr_read<v_rd_off(D0, 3, 1)>(vb);
  asm volatile("s_waitcnt lgkmcnt(0)" ::: "memory"); SBAR();
#define PK(L, H) (bf16x8){L[0], L[1], L[2], L[3], H[0], H[1], H[2], H[3]}
  od = __builtin_amdgcn_mfma_f32_32x32x16_bf16(pa0, PK(l0, h0), od, 0, 0, 0);
  od = __builtin_amdgcn_mfma_f32_32x32x16_bf16(pa1, PK(l1, h1), od, 0, 0, 0);
  od = __builtin_amdgcn_mfma_f32_32x32x16_bf16(pa2, PK(l2, h2), od, 0, 0, 0);
  od = __builtin_amdgcn_mfma_f32_32x32x16_bf16(pa3, PK(l3, h3), od, 0, 0, 0);
#undef PK
}
__device__ __forceinline__ void pv_d0(f32x16* o, int vb, bf16x8 pa0, bf16x8 pa1, bf16x8 pa2, bf16x8 pa3) {
  pv_one<0>(o[0], vb, pa0, pa1, pa2, pa3); pv_one<1>(o[1], vb, pa0, pa1, pa2, pa3); pv_one<2>(o[2], vb, pa0, pa1, pa2, pa3); pv_one<3>(o[3], vb, pa0, pa1, pa2, pa3);
}


__device__ __forceinline__ void band_mask(f32x16& p0, f32x16& p1, int kind, int off, int i, int hi) {
  const int th = i - off - 4 * hi;
  if (kind == 1) {
#pragma unroll
    for (int r = 0; r < 16; ++r) { const int k0 = (r & 3) + 8 * (r >> 2); p0[r] = (k0 < th) ? -1e30f : p0[r]; p1[r] = (32 + k0 < th) ? -1e30f : p1[r]; } }
  else if (kind == 2) {
#pragma unroll
    for (int r = 0; r < 16; ++r) { const int k0 = (r & 3) + 8 * (r >> 2); p0[r] = (k0 > th) ? -1e30f : p0[r]; p1[r] = (32 + k0 > th) ? -1e30f : p1[r]; } }
}
constexpr int NQB = 64, LROWS = 8192;
__device__ __forceinline__ void tile_info(int qb, int t, int& row, int& kind, int& off) {
  kind = 0; off = 0;
  if (qb >= NQB) { row = LROWS + 64 * t; return; }
  if (t < 2) { row = qb * 128 + 64 * t; return; }
  if (t < 6) { row = LROWS + 64 * (t - 2); return; }
  int tt = t - 6; const bool prev = (qb > 0) && (tt < 2); if (!prev && qb > 0) tt -= 2;
  off = 64 * tt; if (prev) { row = (qb - 1) * 128 + off; kind = 1; } else { row = (qb + 1) * 128 + off; kind = 2; }
}
__device__ __forceinline__ void attn_unit(const bf16* __restrict__ P, int ldp, int qoff, int koff, int voff, bf16* __restrict__ O, int ldo, int qb, int kvh, int hq0, const float* __restrict__ sink, char* lds, int tid) {
  const int wid = __builtin_amdgcn_readfirstlane(tid >> 6), lane = tid & 63, r32 = lane & 31, hi = lane >> 5;
  const int hq = hq0 + (wid >> 2), iq = (wid & 3) * 32 + r32;
  bf16* V_lds = (bf16*)lds; bf16* K_lds = (bf16*)(lds + 2 * SHM_V);
  float* ws = (float*)(lds + 2 * SHM_V + 2 * SHM_K) + wid * 64; float* li_l = ws; float* al_l = ws + 32;
  float m_reg = -1e30f, l_reg = 0; f32x16 o[4] = {}; bf16x8 qr[8];
  const bf16* Qw = P + (size_t)(qb * 128 + iq) * ldp + qoff + hq * 128 + hi * 8;
#pragma unroll
  for (int d0 = 0; d0 < 8; ++d0) qr[d0] = *reinterpret_cast<const bf16x8*>(Qw + d0 * 16);
  const int sr = tid >> 4, sc = (tid & 15) * 8, vst0 = v_st(sr, sc), vst1 = v_st(32 + sr, sc);
  const int vb0 = (int)(uintptr_t)V_lds + v_rd_base(lane);
  const bf16* Kg = P + koff + kvh * 128 + sc; const bf16* Vg = P + voff + kvh * 128 + sc;
  struct { bf16x8 vs0, vs1, ks0, ks1; } sr_[SDEPTH];
  const int NT = (qb >= NQB) ? 4 : 6 + (qb > 0 ? 2 : 0) + (qb < NQB - 1 ? 2 : 0);
  int trow, tkind, toff;
#define SLOAD(i, t) do { int kd_, of_; tile_info(qb, (t), trow, kd_, of_); const unsigned r0_ = (unsigned)(trow + sr) * (unsigned)ldp, r1_ = r0_ + 32u * (unsigned)ldp; \
    sr_[i].vs0 = *reinterpret_cast<const bf16x8*>(Vg + r0_); sr_[i].vs1 = *reinterpret_cast<const bf16x8*>(Vg + r1_); \
    sr_[i].ks0 = *reinterpret_cast<const bf16x8*>(Kg + r0_); sr_[i].ks1 = *reinterpret_cast<const bf16x8*>(Kg + r1_); } while (0)
#define SWRITE(b, i) do { *(bf16x8*)((char*)V_lds + (b) * SHM_V + vst0) = sr_[i].vs0;          \
    *(bf16x8*)((char*)V_lds + (b) * SHM_V + vst1) = sr_[i].vs1; int kc = sc * 2;               \
    *(bf16x8*)((char*)K_lds + (b) * SHM_K + KSWZ(sr, kc)) = sr_[i].ks0;                       \
    *(bf16x8*)((char*)K_lds + (b) * SHM_K + KSWZ(32 + sr, kc)) = sr_[i].ks1; } while (0)
#define SWAIT() do { if constexpr (SDEPTH == 2) asm volatile("s_waitcnt vmcnt(4)" ::: "memory"); else asm volatile("s_waitcnt vmcnt(0)" ::: "memory"); } while (0)
#define RESC(a) do { if (__any((a) < 1.f)) { if (hi == 0) al_l[r32] = (a); asm volatile("s_waitcnt lgkmcnt(0)" ::: "memory"); \
    for (int d = 0; d < 4; ++d) for (int r = 0; r < 16; ++r) o[d][r] *= al_l[crow(r, hi)]; } } while (0)
#define MASK(p0, p1, t) do { tile_info(qb, (t), trow, tkind, toff); if (tkind) band_mask(p0, p1, tkind, toff, iq, hi); } while (0)
  f32x16 pA0, pA1, pB0, pB1; float mnA, mnB, alA, alB; bf16x8 pa0, pa1, pa2, pa3;
  constexpr int SE = 0, SO = SDEPTH - 1;
  SLOAD(SE, 0); asm volatile("s_waitcnt vmcnt(0)" ::: "memory"); SWRITE(0, SE); __syncthreads();
  qkt(pA0, pA1, K_lds, qr, r32, hi); partialSM(pA0, pA1, m_reg, mnA, alA);
  SLOAD(SO, 1); if constexpr (SDEPTH == 2) { if (2 < NT) SLOAD(SE, 2); }
  SWAIT(); SWRITE(1, SO); __syncthreads();
  for (int j = 1; j + 1 < NT; j += 2) {
    SBAR(); qkt(pB0, pB1, (bf16*)((char*)K_lds + SHM_K), qr, r32, hi); MASK(pB0, pB1, j);
    finishSM(pA0, pA1, alA, l_reg, pa0, pa1, pa2, pa3); SBAR();
    SLOAD(SO, j + SDEPTH); SBAR();
    pv_d0(o, vb0, pa0, pa1, pa2, pa3); partialSM(pB0, pB1, m_reg, mnB, alB);
    __syncthreads(); SWAIT(); SWRITE(0, SE);
    RESC(alB); __syncthreads();
    SBAR(); qkt(pA0, pA1, K_lds, qr, r32, hi); MASK(pA0, pA1, j + 1);
    finishSM(pB0, pB1, alB, l_reg, pa0, pa1, pa2, pa3); SBAR();
    if (SDEPTH == 1 || j + 3 < NT) SLOAD(SE, j + 1 + SDEPTH); SBAR();
    pv_d0(o, vb0 + (int)SHM_V, pa0, pa1, pa2, pa3); partialSM(pA0, pA1, m_reg, mnA, alA);
    __syncthreads(); SWAIT(); SWRITE(1, SO);
    RESC(alA); __syncthreads();
  }
  SBAR(); qkt(pB0, pB1, (bf16*)((char*)K_lds + SHM_K), qr, r32, hi); MASK(pB0, pB1, NT - 1);
  finishSM(pA0, pA1, alA, l_reg, pa0, pa1, pa2, pa3); SBAR();
  pv_d0(o, vb0, pa0, pa1, pa2, pa3); partialSM(pB0, pB1, m_reg, mnB, alB);
  __syncthreads(); RESC(alB);
  finishSM(pB0, pB1, alB, l_reg, pa0, pa1, pa2, pa3); SBAR();
  pv_d0(o, vb0 + (int)SHM_V, pa0, pa1, pa2, pa3);
  { constexpr float C = SCALE * 1.4426950408889634f; l_reg += __builtin_amdgcn_exp2f(sink[hq] * 1.4426950408889634f - m_reg * C); }
  if (hi == 0) li_l[r32] = l_reg; asm volatile("s_waitcnt lgkmcnt(0)" ::: "memory");
  float rli[16];
#pragma unroll
  for (int r = 0; r < 16; ++r) rli[r] = __builtin_amdgcn_rcpf(li_l[crow(r, hi)]);
  bf16* Ow = O + (size_t)(qb * 128 + (wid & 3) * 32) * ldo + hq * 128;
#pragma unroll
  for (int r = 0; r < 16; ++r) { const int orow = crow(r, hi);
#pragma unroll
    for (int d0 = 0; d0 < 4; ++d0) { const float v = o[d0][r] * rli[r]; unsigned u = __builtin_bit_cast(unsigned, v); u = (u + 0x7fffu + ((u >> 16) & 1u)) >> 16; Ow[(size_t)orow * ldo + d0 * 32 + r32] = (bf16)u; } }
#undef SLOAD
#undef SWRITE
#undef SWAIT
#undef RESC
#undef MASK
}
#undef KSWZ
#undef SBAR
}

constexpr int NWAVES = 8;
constexpr int D = 2048, L = 8192, LC = 256, MALL = L + LC, FF = 5632, NIN = 13312, NMOD = 9;
constexpr int HD = 128, NQH = 16, NKVH = 4;
constexpr int Q_OFF = 0, K_OFF = 2048, V_OFF = 2560, POOL_OFF = 3072, CB_OFF = 4096, CC_OFF = 5120, CX_OFF = 6144, GATE_OFF = 7168;
constexpr int KCAT = 4096;
constexpr float EPS = 1e-6f;
constexpr int NLAYER = 2, NPL = 11, NPHASE = 1 + NLAYER * NPL + 1;

constexpr size_t MiB = 1u << 20;
constexpr size_t WS_CTL = 0, CTL_ZERO_BYTES = 1 * MiB;
constexpr size_t WS_MODS = 1 * MiB;
constexpr size_t WS_ROPE = 1 * MiB + 512 * 1024;
constexpr size_t WS_W = 2 * MiB, W_LAYER = 208 * MiB;
constexpr size_t W_WI1 = 0, W_WO1 = 44 * MiB, W_WIN = 66 * MiB, W_WMRG = 118 * MiB, W_WOUT = 134 * MiB, W_WI2 = 142 * MiB, W_WO2 = 186 * MiB;
constexpr size_t WS_H = 418 * MiB;
constexpr size_t WS_XN = 484 * MiB;
constexpr size_t WS_ACT = 517 * MiB;
constexpr size_t WS_P = 608 * MiB;
constexpr size_t WS_ACAT = 823 * MiB;
constexpr size_t WS_Y3 = 889 * MiB;
constexpr size_t WS_MRG = 988 * MiB;
constexpr size_t WS_C = 1021 * MiB;
constexpr size_t WS_END = 1087 * MiB;
static_assert((size_t)MALL * NIN * 2 <= 215 * MiB && (size_t)MALL * FF * 2 <= 91 * MiB && (size_t)MALL * D * 4 <= 66 * MiB && (size_t)MALL * D * 2 <= 33 * MiB, "d_ws map");
constexpr int CW_Q = 1024;
constexpr int CW_BAR = 4096;

constexpr int RING_OFF = 0, RING_BYTES = 131072;
constexpr int LDSCTL_OFF = RING_BYTES, MISC_OFF = LDSCTL_OFF + 320;
constexpr int LDS_BYTES = 147456;

#define GAS __attribute__((address_space(1)))
#define LAS __attribute__((address_space(3)))
typedef unsigned short bf16;
typedef unsigned v4u __attribute__((ext_vector_type(4)));
typedef unsigned v2u __attribute__((ext_vector_type(2)));
typedef float f32x4 __attribute__((ext_vector_type(4)));
typedef float f32x2 __attribute__((ext_vector_type(2)));
typedef GAS unsigned gu32;
#define RLX_AGENT __ATOMIC_RELAXED, __HIP_MEMORY_SCOPE_AGENT
#define LDS_WAIT() asm volatile("s_waitcnt lgkmcnt(0)" ::: "memory")
#define VM_WAIT() asm volatile("s_waitcnt vmcnt(0)" ::: "memory")
__device__ __forceinline__ unsigned f2bf(float f) { unsigned u = __builtin_bit_cast(unsigned, f); return (u + 0x7fffu + ((u >> 16) & 1u)) >> 16; }
__device__ __forceinline__ unsigned pk2(float lo, float hi) { return f2bf(lo) | (f2bf(hi) << 16); }
__device__ __forceinline__ float bflo(unsigned w) { return __builtin_bit_cast(float, w << 16); }
__device__ __forceinline__ float bfhi(unsigned w) { return __builtin_bit_cast(float, w & 0xffff0000u); }
__device__ __forceinline__ float bf2f(bf16 b) { return __builtin_bit_cast(float, (unsigned)b << 16); }
__device__ __forceinline__ float sigmoidf_(float x) { return 1.0f / (1.0f + __expf(-x)); }
__device__ __forceinline__ float siluf_(float x) { return x / (1.0f + __expf(-x)); }

#define XB_TMO      128
#define XB_XCNT(j)  (256  + 64 * (j))
#define XB_XSUB(j)  (1280 + 64 * (j))
#define XB_XGEN(j)  (2304 + 64 * (j))
#define XB_TOP      3328
#define XB_TOPGEN   3392
#define XCD_BAR_WORDS 3456
#define XB_SPIN_CAP (1u << 18)

__device__ __forceinline__ unsigned xb_ld(unsigned* p)              { return __hip_atomic_load(p, __ATOMIC_RELAXED, __HIP_MEMORY_SCOPE_AGENT); }
__device__ __forceinline__ unsigned xb_add(unsigned* p, unsigned v) { return __hip_atomic_fetch_add(p, v, __ATOMIC_RELAXED, __HIP_MEMORY_SCOPE_AGENT); }
__device__ __forceinline__ unsigned xb_xcc_id() { return (unsigned)__builtin_amdgcn_s_getreg((3 << 11) | 20) & 0xFu; }
#define XB_SPIN(cond, bar) do { unsigned _sp = 0; while (cond) { __builtin_amdgcn_s_sleep(1); \
    if ((++_sp & 255u) == 0u) { if (xb_ld(&(bar)[XB_TMO])) break; if (_sp > XB_SPIN_CAP) { atomicAdd(&(bar)[XB_TMO], 1u); break; } } } } while (0)

struct XcdBarrier {
    unsigned* bar; unsigned x;
    volatile LAS unsigned* st;
};

__device__ __forceinline__ XcdBarrier xcd_barrier_post(unsigned* bar, volatile LAS unsigned* st, int tid) {
    XcdBarrier b; b.bar = bar; b.x = xb_xcc_id(); b.st = st;
    if (tid == 0) (void)xb_add(&bar[XB_XCNT(b.x)], 1u);
    return b;
}
__device__ __forceinline__ void xcd_barrier_complete(unsigned* bar, unsigned x, unsigned& nloc, unsigned& nx) {
    const unsigned G = gridDim.x * gridDim.y * gridDim.z;
    unsigned sum, cnt, mine, sp = 0u;
    for (;;) {
        sum = 0u; cnt = 0u; mine = 0u;
#pragma unroll
        for (unsigned j = 0; j < 16; ++j) { const unsigned c = xb_ld(&bar[XB_XCNT(j)]); sum += c; cnt += (c > 0u) ? 1u : 0u; mine = (j == x) ? c : mine; }
        if (sum == G) break;
        __builtin_amdgcn_s_sleep(1);
        if ((++sp & 255u) == 0u) { if (xb_ld(&bar[XB_TMO])) break; if (sp > XB_SPIN_CAP) { atomicAdd(&bar[XB_TMO], 1u); break; } }
    }
    nloc = mine > 0u ? mine : 1u; nx = cnt > 0u ? cnt : 1u;
}

__device__ __forceinline__ void xcd_barrier(const XcdBarrier& b, int tid) {
    asm volatile("s_waitcnt vmcnt(0)" ::: "memory");
    __syncthreads();
    if (tid == 0) {
        unsigned* bar = b.bar;
        __builtin_amdgcn_s_waitcnt(0);
        unsigned nloc = b.st[0], nx = b.st[1];
        if (nloc == 0u) { xcd_barrier_complete(bar, b.x, nloc, nx); b.st[0] = nloc; b.st[1] = nx; }
        const unsigned old = xb_add(&bar[XB_XSUB(b.x)], 1u);
        const unsigned gen = old / nloc;
        if (old + 1u == (gen + 1u) * nloc) {
            __builtin_amdgcn_fence(__ATOMIC_RELEASE, "agent");
            asm volatile("s_waitcnt vmcnt(0)" ::: "memory");
            const unsigned og = xb_add(&bar[XB_TOP], 1u);
            const unsigned tg = og / nx;
            if (og + 1u == (tg + 1u) * nx) xb_add(&bar[XB_TOPGEN], 1u);
            else XB_SPIN(xb_ld(&bar[XB_TOPGEN]) == tg, bar);
            __builtin_amdgcn_fence(__ATOMIC_ACQUIRE, "agent");
            xb_add(&bar[XB_XGEN(b.x)], 1u);
            asm volatile("s_waitcnt vmcnt(0)" ::: "memory");
        } else {
            XB_SPIN(xb_ld(&bar[XB_XGEN(b.x)]) == gen, bar);
            __builtin_amdgcn_fence(__ATOMIC_ACQUIRE, "agent");
            asm volatile("s_waitcnt vmcnt(0)" ::: "memory");
        }
    }
    __syncthreads();
}


struct Args { const float* in[21]; float* out; unsigned char* ws; int ph_lo, ph_hi; };
struct Frame {
    LAS unsigned char* lds;
    volatile LAS unsigned* MISC;
    gu32* ctl;
    int tid, wave;
    int vcu, G;
    float* out;
    unsigned char* ws;
};
__device__ __forceinline__ float wave_sum(float v, int lane) {
#pragma unroll
    for (int o = 1; o < 64; o <<= 1) v += __builtin_bit_cast(float, __builtin_amdgcn_ds_bpermute((lane ^ o) << 2, __builtin_bit_cast(int, v)));
    return v;
}
__constant__ float ROPE_INV[32] = {1.f, 0.749894261f, 0.562341332f, 0.421696514f, 0.316227764f, 0.237137377f, 0.177827939f, 0.133352131f, 0.100000001f, 0.0749894157f, 0.0562341325f, 0.0421696529f,
    0.0316227749f, 0.0237137377f, 0.0177827943f, 0.0133352149f, 0.00999999978f, 0.00749894185f, 0.00562341325f, 0.00421696482f, 0.00316227763f, 0.00237137359f, 0.00177827943f, 0.00133352145f,
    0.00100000005f, 0.000749894243f, 0.000562341302f, 0.000421696517f, 0.000316227757f, 0.00023713737f, 0.00017782794f, 0.00013335215f};

template <int MODE> __device__ __forceinline__ int rowmap(int n) {
    if (MODE == 1) { const int bj = n >= FF ? 1 : 0, j = n - bj * FF; return (j >> 7) * 256 + bj * 128 + (j & 127); }
    if (MODE == 2) { if (n >= 2560) return n; const int h = n >> 7, d = n & 127, axis = d >> 6, nn = (d >> 5) & 1, pi = d & 31, wc = axis * 2 + (pi >> 4), fq = (pi >> 2) & 3, i = pi & 3; return h * 128 + 32 * wc + 8 * fq + 4 * nn + i; }
    return n;
}
template <int MODE>
__device__ __forceinline__ void xpose_item(const float* W, int N, bf16* WT, int ldk, int koff, LAS float* scr, int item, int lane) {
    const int nblk = N / 32, kb = item / nblk, nb = item % nblk, k0 = 64 * kb, n0 = 32 * nb;
#pragma unroll 8
    for (int i = 0; i < 32; ++i) { const int kk = 2 * i + (lane >> 5); scr[kk * 33 + (lane & 31)] = W[(size_t)(k0 + kk) * N + n0 + (lane & 31)]; }
    LDS_WAIT(); asm volatile("" ::: "memory");
    const int c = lane & 7;
#pragma unroll
    for (int j = 0; j < 4; ++j) { const int n = (lane >> 3) + 8 * j; const LAS float* s = scr + (8 * c) * 33 + n;
        v4u o; o.x = pk2(s[0 * 33], s[1 * 33]); o.y = pk2(s[2 * 33], s[3 * 33]); o.z = pk2(s[4 * 33], s[5 * 33]); o.w = pk2(s[6 * 33], s[7 * 33]);
        *(GAS v4u*)(WT + (size_t)rowmap<MODE>(n0 + n) * ldk + koff + k0 + 8 * c) = o; }
    LDS_WAIT(); asm volatile("" ::: "memory");
}
__device__ __forceinline__ void sincos_d(double a, float& c, float& s) {
    const double TWO_PI = 6.283185307179586476925, HALF_PI = 1.570796326794896619231;
    const double n = __builtin_rint(a * (1.0 / TWO_PI)); double r = a - n * TWO_PI;
    const double q = __builtin_rint(r * (1.0 / HALF_PI)); const double y = r - q * HALF_PI, y2 = y * y;
    const double sy = y * (1.0 - y2 / 6.0 * (1.0 - y2 / 20.0 * (1.0 - y2 / 42.0 * (1.0 - y2 / 72.0 * (1.0 - y2 / 110.0 * (1.0 - y2 / 156.0 * (1.0 - y2 / 210.0)))))));
    const double cy = 1.0 - y2 / 2.0 * (1.0 - y2 / 12.0 * (1.0 - y2 / 30.0 * (1.0 - y2 / 56.0 * (1.0 - y2 / 90.0 * (1.0 - y2 / 132.0 * (1.0 - y2 / 182.0))))));
    const int qi = ((int)q) & 3;
    const double cc = (qi == 0) ? cy : (qi == 1) ? -sy : (qi == 2) ? -cy : sy;
    const double ss = (qi == 0) ? sy : (qi == 1) ? cy : (qi == 2) ? -sy : -cy;
    c = (float)cc; s = (float)ss;
}

struct CvtJob { const float* src; bf16* dst; int N, ldk, koff, mode, nblocks; };
__device__ __forceinline__ CvtJob cvt_job(const Args& A, unsigned char* ws, int jg) {
    const int l = jg >> 3, j = jg & 7; unsigned char* wl = ws + WS_W + (size_t)l * W_LAYER; CvtJob J;
    switch (j) {
    case 0: J = CvtJob{A.in[7] + (size_t)l * D * 2 * FF, (bf16*)(wl + W_WI1), 2 * FF, D, 0, 1, (D / 256) * (2 * FF / 128)}; break;
    case 1: J = CvtJob{A.in[8] + (size_t)l * FF * D, (bf16*)(wl + W_WO1), D, FF, 0, 0, (FF / 256) * (D / 128)}; break;
    case 2: J = CvtJob{A.in[9] + (size_t)l * D * NIN, (bf16*)(wl + W_WIN), NIN, D, 0, 2, (D / 256) * (NIN / 128)}; break;
    case 3: J = CvtJob{A.in[14] + (size_t)l * D * D, (bf16*)(wl + W_WMRG), D, KCAT, 0, 0, (D / 256) * (D / 128)}; break;
    case 4: J = CvtJob{A.in[16] + (size_t)l * 1024 * D, (bf16*)(wl + W_WMRG), D, KCAT, 3072, 0, (1024 / 256) * (D / 128)}; break;
    case 5: J = CvtJob{A.in[17] + (size_t)l * D * D, (bf16*)(wl + W_WOUT), D, D, 0, 0, (D / 256) * (D / 128)}; break;
    case 6: J = CvtJob{A.in[18] + (size_t)l * D * 2 * FF, (bf16*)(wl + W_WI2), 2 * FF, D, 0, 1, (D / 256) * (2 * FF / 128)}; break;
    default: J = CvtJob{A.in[19] + (size_t)l * FF * D, (bf16*)(wl + W_WO2), D, FF, 0, 0, (FF / 256) * (D / 128)}; break;
    }
    return J;
}
__device__ __forceinline__ int rowmap_rt(int mode, int n) { return mode == 1 ? rowmap<1>(n) : (mode == 2 ? rowmap<2>(n) : n); }
struct CvtBlk { const float* src; bf16* dst; int N, ldk, mode, n0; bool ok; };
__device__ __forceinline__ CvtBlk cvt_decode(const Args& A, unsigned char* ws, int j0, int j1, int b) {
    CvtBlk I; I.ok = false; I.src = nullptr; I.dst = nullptr; I.N = 0; I.ldk = 0; I.mode = 0; I.n0 = 0;
    for (int jg = j0; jg < j1; ++jg) { const CvtJob J = cvt_job(A, ws, jg);
        if (b < J.nblocks) { const int nblk = J.N >> 7, kb = b / nblk, nb = b - kb * nblk; I.src = J.src + (size_t)(256 * kb) * J.N + 128 * nb; I.dst = J.dst + J.koff + 256 * kb; I.N = J.N; I.ldk = J.ldk; I.mode = J.mode; I.n0 = 128 * nb; I.ok = true; break; }
        b -= J.nblocks; }
    return I;
}
constexpr int CVT_PITCH = 528;
__device__ __forceinline__ void cvt_load(const CvtBlk& I, f32x4 (&v)[16], int tid) {
    const float* p = I.src + (size_t)(8 * (tid >> 5)) * I.N + 4 * (tid & 31);
#pragma unroll
    for (int g = 0; g < 2; ++g)
#pragma unroll
        for (int j = 0; j < 8; ++j) v[g * 8 + j] = *(const GAS f32x4*)(p + (size_t)(128 * g + j) * I.N);
}
__device__ __forceinline__ void cvt_to_lds(const f32x4 (&v)[16], LAS unsigned char* tile, int tid) {
    const int n4 = tid & 31, kr = tid >> 5;
#pragma unroll
    for (int g = 0; g < 2; ++g)
#pragma unroll
        for (int e = 0; e < 4; ++e) { v4u o; o.x = pg8::cvt_pk_bf16(v[g * 8 + 0][e], v[g * 8 + 1][e]); o.y = pg8::cvt_pk_bf16(v[g * 8 + 2][e], v[g * 8 + 3][e]);
            o.z = pg8::cvt_pk_bf16(v[g * 8 + 4][e], v[g * 8 + 5][e]); o.w = pg8::cvt_pk_bf16(v[g * 8 + 6][e], v[g * 8 + 7][e]);
            *(LAS v4u*)(tile + (4 * n4 + e) * CVT_PITCH + (kr + 16 * g) * 16) = o; }
}
__device__ __forceinline__ void cvt_from_lds(const CvtBlk& I, LAS unsigned char* tile, int tid) {
    const int kg = tid & 31, nsub = tid >> 5;
#pragma unroll
    for (int i = 0; i < 8; ++i) { const int n = 16 * i + nsub; const v4u o = *(LAS v4u*)(tile + n * CVT_PITCH + kg * 16);
        *(GAS v4u*)(I.dst + (size_t)rowmap_rt(I.mode, I.n0 + n) * I.ldk + 8 * kg) = o; }
}
__device__ __forceinline__ void convert_jobs(Frame& F, const Args& A, int j0, int j1, gu32* qword) {
    int total = 0; for (int jg = j0; jg < j1; ++jg) total += cvt_job(A, F.ws, jg).nblocks;
    LAS unsigned char* tile = F.lds;
    if (F.tid == 0) F.MISC[12] = __hip_atomic_fetch_add(qword, 1u, RLX_AGENT);
    __syncthreads();
    int b = (int)F.MISC[12], par = 1;
    CvtBlk cur = cvt_decode(A, F.ws, j0, j1, b < total ? b : 0); cur.ok = cur.ok && (b < total);
    f32x4 va[16], vb[16];
    if (cur.ok) cvt_load(cur, va, F.tid);
    while (cur.ok) {
        if (F.tid == 0) F.MISC[12 + par] = __hip_atomic_fetch_add(qword, 1u, RLX_AGENT);
        cvt_to_lds(va, tile, F.tid);
        __syncthreads();
        b = (int)F.MISC[12 + par]; par ^= 1;
        CvtBlk nxt = cvt_decode(A, F.ws, j0, j1, b < total ? b : 0); nxt.ok = nxt.ok && (b < total);
        if (nxt.ok) cvt_load(nxt, vb, F.tid);
        cvt_from_lds(cur, tile, F.tid);
        __syncthreads();
        cur = nxt;
#pragma unroll
        for (int i = 0; i < 16; ++i) va[i] = vb[i];
    }
    __syncthreads();
}
__device__ __forceinline__ void p0_prologue(Frame& F, const Args& A) {
    const int gw = F.vcu * NWAVES + F.wave, NGW = F.G * NWAVES;
    const int gtid = F.vcu * 512 + F.tid, NGT = F.G * 512;
    {
        LAS float* sil = (LAS float*)(F.lds + 69632);
        LAS float* red = (LAS float*)(F.lds + 86016);
        const float* c = A.in[1]; const float* cc = A.in[3]; const float* w_ada = A.in[4]; const float* b_ada = A.in[5];
        float* mods = (float*)(F.ws + WS_MODS);
        for (int i = F.tid; i < 2048; i += 512) { sil[i] = siluf_(c[i]); sil[2048 + i] = siluf_(cc[i]); }
        __syncthreads();
        for (int it = F.vcu; it < 2 * 72; it += F.G) {
            const int l = it / 72, nb = it % 72, n0 = nb * 256 + 4 * (F.tid & 63);
            f32x4 a0 = {0.f, 0.f, 0.f, 0.f}, a1 = {0.f, 0.f, 0.f, 0.f};
            const float* wp = w_ada + (size_t)l * 2048 * 18432 + n0;
#pragma unroll 8
            for (int k = F.wave; k < 2048; k += 8) { const f32x4 wv = *(const GAS f32x4*)(wp + (size_t)k * 18432); const float s0 = sil[k], s1 = sil[2048 + k]; a0 += wv * s0; a1 += wv * s1; }
            *(LAS f32x4*)(red + (F.wave * 2 + 0) * 256 + 4 * (F.tid & 63)) = a0; *(LAS f32x4*)(red + (F.wave * 2 + 1) * 256 + 4 * (F.tid & 63)) = a1;
            __syncthreads();
            { const int v = F.tid >> 8, col = F.tid & 255; float s = 0.f;
#pragma unroll
              for (int w = 0; w < 8; ++w) s += red[(w * 2 + v) * 256 + col];
              mods[(size_t)(l * 2 + v) * 18432 + nb * 256 + col] = s + b_ada[l * 18432 + nb * 256 + col]; }
            __syncthreads();
        }
    }
    { f32x2* tab = (f32x2*)(F.ws + WS_ROPE);
      for (int i = gtid; i < 128 * 32; i += NGT) { const int pos = i >> 5, pi = i & 31; const float ang = (float)pos * ROPE_INV[pi]; float c, s; sincos_d((double)ang, c, s); tab[i] = (f32x2){c, s}; } }
    { const GAS f32x4* x4 = (const GAS f32x4*)A.in[0]; const GAS f32x4* c4 = (const GAS f32x4*)A.in[2]; GAS f32x4* h4 = (GAS f32x4*)(F.ws + WS_H);
      for (int i = gtid; i < L * D / 4; i += NGT) h4[i] = x4[i];
      for (int i = gtid; i < LC * D / 4; i += NGT) h4[L * D / 4 + i] = c4[i]; }
    for (int it = gw; it < 2 * 4 * 32 * 32; it += NGW) {
        const int dblk = it & 31, c8 = (it >> 5) & 31, g = (it >> 10) & 3, l = it >> 12;
        const int d = dblk * 64 + (F.tid & 63);
        const float* pw = A.in[11] + ((size_t)(l * 4 + g) * 256 + c8 * 8) * 256;
        const float* sc = A.in[12] + l * 1024 + g * 256;
        const float* wpo = A.in[15] + ((size_t)l * 1024 + g * 256) * 2048 + d;
        float acc[8];
#pragma unroll
        for (int i = 0; i < 8; ++i) acc[i] = 0.f;
#pragma unroll 4
        for (int j = 0; j < 256; ++j) { const float t = sc[j] * wpo[(size_t)j * 2048];
#pragma unroll
            for (int i = 0; i < 8; ++i) acc[i] += pw[i * 256 + j] * t; }
        bf16* wt = (bf16*)(F.ws + WS_W + (size_t)l * W_LAYER + W_WMRG);
        v4u o; o.x = pk2(acc[0], acc[1]); o.y = pk2(acc[2], acc[3]); o.z = pk2(acc[4], acc[5]); o.w = pk2(acc[6], acc[7]);
        *(GAS v4u*)(wt + (size_t)d * KCAT + 2048 + g * 256 + c8 * 8) = o;
    }
    __syncthreads();
    convert_jobs(F, A, 0, 1, F.ctl + CW_Q + 0 * 64);
}

template <bool FINAL>
__device__ __forceinline__ void norm_rows(Frame& F, const float* mv, const float* gnorm, int shift_idx, int scale_idx, int r_begin, int r_end, int r_first, int r_step) {
    const int lane = F.tid & 63;
    const float* H = (const float*)(F.ws + WS_H); bf16* XN = (bf16*)(F.ws + WS_XN);
    if (r_first >= r_end) return;
    f32x4 ca[8], cb[8];
#pragma unroll
    for (int j = 0; j < 8; ++j) { const int col = 4 * lane + 256 * j; ca[j] = *(const GAS f32x4*)(gnorm + col);
        if (!FINAL) { const f32x4 sc = *(const GAS f32x4*)(mv + scale_idx * 2048 + col); cb[j] = *(const GAS f32x4*)(mv + shift_idx * 2048 + col); ca[j] = ca[j] * (sc + 1.0f); } }
    for (int r = r_first; r < r_end; r += 2 * r_step) {
        const int r2 = r + r_step; const bool two = r2 < r_end; const int rb = two ? r2 : r;
        const GAS f32x4* h0 = (const GAS f32x4*)(H + (size_t)r * D) + lane; const GAS f32x4* h1 = (const GAS f32x4*)(H + (size_t)rb * D) + lane;
        f32x4 x[8], y[8];
#pragma unroll
        for (int j = 0; j < 8; ++j) x[j] = h0[64 * j];
#pragma unroll
        for (int j = 0; j < 8; ++j) y[j] = h1[64 * j];
        float s0 = 0.f, s1 = 0.f;
#pragma unroll
        for (int j = 0; j < 8; ++j) { s0 += (x[j].x * x[j].x + x[j].y * x[j].y) + (x[j].z * x[j].z + x[j].w * x[j].w); s1 += (y[j].x * y[j].x + y[j].y * y[j].y) + (y[j].z * y[j].z + y[j].w * y[j].w); }
#pragma unroll
        for (int o = 1; o < 64; o <<= 1) { s0 += __builtin_bit_cast(float, __builtin_amdgcn_ds_bpermute((lane ^ o) << 2, __builtin_bit_cast(int, s0))); s1 += __builtin_bit_cast(float, __builtin_amdgcn_ds_bpermute((lane ^ o) << 2, __builtin_bit_cast(int, s1))); }
        const float rs0 = 1.0f / sqrtf(s0 * (1.0f / D) + EPS), rs1 = 1.0f / sqrtf(s1 * (1.0f / D) + EPS);
        if (FINAL) { GAS f32x4* o0 = (GAS f32x4*)(F.out + (size_t)r * D) + lane; GAS f32x4* o1 = (GAS f32x4*)(F.out + (size_t)rb * D) + lane;
#pragma unroll
            for (int j = 0; j < 8; ++j) o0[64 * j] = x[j] * rs0 * ca[j];
            if (two) {
#pragma unroll
                for (int j = 0; j < 8; ++j) o1[64 * j] = y[j] * rs1 * ca[j]; } }
        else { GAS v2u* o0 = (GAS v2u*)(XN + (size_t)r * D) + lane; GAS v2u* o1 = (GAS v2u*)(XN + (size_t)rb * D) + lane;
#pragma unroll
            for (int j = 0; j < 8; ++j) { const f32x4 z = x[j] * rs0 * ca[j] + cb[j]; v2u w; w.x = pk2(z.x, z.y); w.y = pk2(z.z, z.w); o0[64 * j] = w; }
            if (two) {
#pragma unroll
                for (int j = 0; j < 8; ++j) { const f32x4 z = y[j] * rs1 * ca[j] + cb[j]; v2u w; w.x = pk2(z.x, z.y); w.y = pk2(z.z, z.w); o1[64 * j] = w; } } }
    }
}
template <bool FINAL>
__device__ __forceinline__ void norm_phase(Frame& F, int l, const float* gnorm, int shift_idx, int scale_idx) {
    const int gw = F.vcu * NWAVES + F.wave, NGW = F.G * NWAVES;
    const float* mods = (const float*)(F.ws + WS_MODS) + (size_t)(l * 2) * 18432;
    norm_rows<FINAL>(F, mods, gnorm, shift_idx, scale_idx, 0, L, gw, NGW);
    if (!FINAL) norm_rows<false>(F, mods + 18432, gnorm, shift_idx, scale_idx, L, MALL, L + gw, NGW);
}

__device__ __forceinline__ void prep_phase(Frame& F, const float* conv_w) {
    const bf16* P = (const bf16*)(F.ws + WS_P); bf16* ACAT = (bf16*)(F.ws + WS_ACAT);
    const int gtid = F.vcu * 512 + F.tid, NGT = F.G * 512;
    for (int i = gtid; i < MALL * 128; i += NGT) { const int r = i >> 7, c = (i & 127) * 8, g = c >> 8, w = 2 << g;
        const int s0 = (r >= L) ? L : 0, sl = (r >= L) ? LC : L, tt0 = r - s0;
        int lo = tt0 - (w >> 1); lo = lo < 0 ? 0 : lo; int hi = tt0 + (w - (w >> 1)) - 1; hi = hi > sl - 1 ? sl - 1 : hi;
        float acc[8];
#pragma unroll
        for (int k = 0; k < 8; ++k) acc[k] = 0.f;
        for (int tt = lo; tt <= hi; ++tt) { const v4u u = *(const GAS v4u*)(P + (size_t)(s0 + tt) * NIN + POOL_OFF + c);
#pragma unroll
            for (int k = 0; k < 4; ++k) { acc[2 * k] += bflo(u[k]); acc[2 * k + 1] += bfhi(u[k]); } }
        const float inv = 1.0f / (float)(hi - lo + 1); const v4u u = *(const GAS v4u*)(P + (size_t)r * NIN + POOL_OFF + c); v4u o;
#pragma unroll
        for (int k = 0; k < 4; ++k) o[k] = pk2(acc[2 * k] * inv - bflo(u[k]), acc[2 * k + 1] * inv - bfhi(u[k]));
        *(GAS v4u*)(ACAT + (size_t)r * KCAT + 2048 + c) = o; }
    const float* cw = conv_w;
    for (int i = gtid; i < MALL * 128; i += NGT) { const int r = i >> 7, c = (i & 127) * 8;
        const int s0 = (r >= L) ? L : 0, sl = (r >= L) ? LC : L, tt0 = r - s0;
        float cx[3][8];
#pragma unroll
        for (int dt = 0; dt < 3; ++dt) { const int tt = tt0 + dt - 1;
            if (tt >= 0 && tt < sl) { const bf16* pr = P + (size_t)(s0 + tt) * NIN; const v4u cg = *(const GAS v4u*)(pr + CC_OFF + c), xv = *(const GAS v4u*)(pr + CX_OFF + c);
#pragma unroll
                for (int k = 0; k < 4; ++k) { cx[dt][2 * k] = bflo(cg[k]) * bflo(xv[k]); cx[dt][2 * k + 1] = bfhi(cg[k]) * bfhi(xv[k]); } }
            else {
#pragma unroll
                for (int k = 0; k < 8; ++k) cx[dt][k] = 0.f; } }
        const v4u bg = *(const GAS v4u*)(P + (size_t)r * NIN + CB_OFF + c); float y[8];
#pragma unroll
        for (int k = 0; k < 8; ++k) y[k] = cx[0][k] * cw[c + k] + cx[1][k] * cw[1024 + c + k] + cx[2][k] * cw[2048 + c + k];
        v4u o;
#pragma unroll
        for (int k = 0; k < 4; ++k) o[k] = pk2(bflo(bg[k]) * y[2 * k], bfhi(bg[k]) * y[2 * k + 1]);
        *(GAS v4u*)(ACAT + (size_t)r * KCAT + 3072 + c) = o; }
}

typedef short s16x8 __attribute__((ext_vector_type(8)));
typedef float f32x16 __attribute__((ext_vector_type(16)));
__device__ __forceinline__ f32x4 mini_tile(const bf16* A, int lda, const bf16* Bt, int ldb, int k0, int klen, int r0, int c0, LAS float* red, int tid) {
    const int wave = __builtin_amdgcn_readfirstlane(tid >> 6), lane = tid & 63, r32 = lane & 31, hi = lane >> 5;
    const int kw = klen >> 3, kb = k0 + wave * kw;
    const bf16* ap = A + (size_t)(r0 + r32) * lda + kb + 8 * hi; const bf16* b0p = Bt + (size_t)(c0 + r32) * ldb + kb + 8 * hi; const bf16* b1p = b0p + (size_t)32 * ldb;
    f32x16 acc0 = {}, acc1 = {};
#pragma unroll 4
    for (int k = 0; k < kw; k += 16) { const s16x8 a = *(const GAS s16x8*)(ap + k), b0 = *(const GAS s16x8*)(b0p + k), b1 = *(const GAS s16x8*)(b1p + k);
        acc0 = __builtin_amdgcn_mfma_f32_32x32x16_bf16(a, b0, acc0, 0, 0, 0); acc1 = __builtin_amdgcn_mfma_f32_32x32x16_bf16(a, b1, acc1, 0, 0, 0); }
#pragma unroll
    for (int r = 0; r < 16; ++r) { const int row = (r & 3) + 8 * (r >> 2) + 4 * hi; red[(wave * 32 + row) * 64 + r32] = acc0[r]; red[(wave * 32 + row) * 64 + 32 + r32] = acc1[r]; }
    __syncthreads();
    const int row = tid >> 4, c4 = (tid & 15) * 4; f32x4 s = {0.f, 0.f, 0.f, 0.f};
#pragma unroll
    for (int w = 0; w < 8; ++w) s += *(LAS f32x4*)(red + (w * 32 + row) * 64 + c4);
    __syncthreads();
    return s;
}
__device__ __forceinline__ void ctx_resid(Frame& F, const bf16* A, int lda, const bf16* Bt, int K, const float* gate, float gs) {
    float* H = (float*)(F.ws + WS_H);
    for (int mt = F.vcu; mt < 256; mt += F.G) { const int r0 = (mt >> 5) * 32, c0 = (mt & 31) * 64;
        const f32x4 v = mini_tile(A + (size_t)L * lda, lda, Bt, K, 0, K, r0, c0, (LAS float*)F.lds, F.tid);
        const int row = L + r0 + (F.tid >> 4), col = c0 + 4 * (F.tid & 15);
        f32x4* p = (f32x4*)(H + (size_t)row * D + col); *p = *p + *(const f32x4*)(gate + col) * gs * v; }
}
__device__ __forceinline__ void ctx_merge(Frame& F, const bf16* Bt) {
    const bf16* ACAT = (const bf16*)(F.ws + WS_ACAT); const bf16* P = (const bf16*)(F.ws + WS_P); bf16* MRG = (bf16*)(F.ws + WS_MRG);
    for (int mt = F.vcu; mt < 256; mt += F.G) { const int r0 = (mt >> 5) * 32, c0 = (mt & 31) * 64;
        const int row = L + r0 + (F.tid >> 4), col = c0 + 4 * (F.tid & 15); f32x4 s = {0.f, 0.f, 0.f, 0.f};
#pragma unroll
        for (int sg = 0; sg < 3; ++sg) { const int k0 = sg == 0 ? 0 : (sg == 1 ? 2048 : 3072), kl = sg == 0 ? 2048 : 1024;
            const f32x4 v = mini_tile(ACAT + (size_t)L * KCAT, KCAT, Bt, KCAT, k0, kl, r0, c0, (LAS float*)F.lds, F.tid);
            const v2u gw = *(const GAS v2u*)(P + (size_t)row * NIN + GATE_OFF + sg * D + col);
            s[0] += bflo(gw.x) * v[0]; s[1] += bfhi(gw.x) * v[1]; s[2] += bflo(gw.y) * v[2]; s[3] += bfhi(gw.y) * v[3]; }
        v2u w; w.x = pk2(s[0], s[1]); w.y = pk2(s[2], s[3]); *(GAS v2u*)(MRG + (size_t)row * D + col) = w; }
}

__device__ __forceinline__ void attn_phase(Frame& F, const float* sink, int nunits, char* lds) {
    const bf16* P = (const bf16*)(F.ws + WS_P); bf16* ACAT = (bf16*)(F.ws + WS_ACAT);
    for (int u = F.vcu; u < nunits; u += F.G) { const int hp = u & 1, kvh = (u >> 1) & 3, qb = u >> 3;
        att::attn_unit(P, NIN, Q_OFF, K_OFF, V_OFF, ACAT, KCAT, qb, kvh, kvh * 4 + hp * 2, sink, lds, F.tid); }
    __syncthreads();
}

__global__ void __launch_bounds__(NWAVES * 64, 2) fwd(Args args) {
    extern __shared__ __attribute__((aligned(16))) unsigned char lds[];
    Frame F;
    F.lds = (LAS unsigned char*)lds;
    F.MISC = (volatile LAS unsigned*)(F.lds + MISC_OFF);
    F.tid = threadIdx.x; F.wave = __builtin_amdgcn_readfirstlane(F.tid >> 6);
    F.G = gridDim.x; { const int bx = blockIdx.x; F.vcu = (F.G % 8 == 0) ? (bx % 8) * (F.G / 8) + bx / 8 : bx; }
    F.ws = args.ws; F.out = args.out; F.ctl = (gu32*)(args.ws + WS_CTL);
    for (int u = F.tid; u < (LDS_BYTES - LDSCTL_OFF) / 4; u += NWAVES * 64) ((LAS unsigned*)(F.lds + LDSCTL_OFF))[u] = 0u;
    __syncthreads();
    const int lo = args.ph_lo, hi = args.ph_hi;
    XcdBarrier bar; bar.bar = (unsigned*)(F.ctl + CW_BAR); bar.x = 0; bar.st = nullptr;
    if (hi - lo > 1) bar = xcd_barrier_post((unsigned*)(F.ctl + CW_BAR), F.MISC + 8, F.tid);
#define IN(k) (lo <= (k) && (k) < hi)
#define SEAM(k) do { if (IN(k) && IN((k) + 1)) xcd_barrier(bar, F.tid); } while (0)
    int bx = blockIdx.x;
#define LAUNDER() do { asm volatile("" : "+v"(F.tid)); asm volatile("" : "+s"(F.wave), "+s"(F.vcu), "+s"(F.G), "+s"(bx)); } while (0)
    bf16* XN = (bf16*)(F.ws + WS_XN); bf16* ACT = (bf16*)(F.ws + WS_ACT); bf16* P = (bf16*)(F.ws + WS_P); bf16* ACAT = (bf16*)(F.ws + WS_ACAT);
    bf16* MRG = (bf16*)(F.ws + WS_MRG); float* C = (float*)(F.ws + WS_C); float* Hs = (float*)(F.ws + WS_H);

    LAUNDER(); if (IN(0)) { p0_prologue(F, args); } SEAM(0);

    for (int l = 0; l < NLAYER; ++l) {
        const int pb = 1 + l * NPL; const bool lastl = (l == NLAYER - 1);
        unsigned char* wl = F.ws + WS_W + (size_t)l * W_LAYER;
        const float* ng = args.in[6] + (size_t)l * 3 * D;
        const float* mlat = (const float*)(F.ws + WS_MODS) + (size_t)(l * 2 + 0) * 18432; const float* mctx = mlat + 18432;
        LAUNDER(); if (IN(pb + 0)) norm_phase<false>(F, l, ng, 0, 1);
        SEAM(pb + 0);
        LAUNDER(); if (IN(pb + 1)) { pg8::Gemm g{XN, (const bf16*)(wl + W_WI1), D}; pg8::StaticOrder S; S.init(MALL, 2 * FF, D, F.G, bx); pg8::EpiSwiglu E{ACT, FF};
            pg8::gemm_phase<pg8::EpiSwiglu, pg8::StaticOrder, true, true>(F.lds + RING_OFF, g, S, E, F.tid);
            convert_jobs(F, args, 8 * l + 1, 8 * l + 3, F.ctl + CW_Q + (1 + 3 * l) * 64); }
        SEAM(pb + 1);
        LAUNDER(); if (IN(pb + 2)) { pg8::Gemm g{ACT, (const bf16*)(wl + W_WO1), FF}; pg8::StaticOrder S; S.init(L, D, FF, F.G, bx); pg8::EpiResid E{Hs, D, mlat + 2 * D, 0.5f};
            pg8::gemm_phase<pg8::EpiResid, pg8::StaticOrder, true, true>(F.lds + RING_OFF, g, S, E, F.tid);
            ctx_resid(F, ACT, FF, (const bf16*)(wl + W_WO1), FF, mctx + 2 * D, 0.5f); }
        SEAM(pb + 2);
        LAUNDER(); if (IN(pb + 3)) norm_phase<false>(F, l, ng + D, 3, 4);
        SEAM(pb + 3);
        LAUNDER(); if (IN(pb + 4)) { pg8::Gemm g{XN, (const bf16*)(wl + W_WIN), D}; pg8::StaticOrder S; S.init(MALL, NIN, D, F.G, bx); pg8::EpiIn E{P, NIN, (const float*)(F.ws + WS_ROPE), L, 10, 28};
            pg8::gemm_phase<pg8::EpiIn, pg8::StaticOrder, true, true>(F.lds + RING_OFF, g, S, E, F.tid);
            convert_jobs(F, args, 8 * l + 3, 8 * l + 7, F.ctl + CW_Q + (2 + 3 * l) * 64); }
        SEAM(pb + 4);
        LAUNDER(); if (IN(pb + 5)) { attn_phase(F, args.in[10] + l * NQH, lastl ? 512 : 528, (char*)lds + RING_OFF); prep_phase(F, args.in[13] + (size_t)l * 3 * 1024); }
        SEAM(pb + 5);
        LAUNDER(); if (IN(pb + 6)) { pg8::Gemm g{ACAT, (const bf16*)(wl + W_WMRG), KCAT}; pg8::SegOrder S; S.init(L, D, KCAT, F.G, bx); pg8::EpiMerge E{P, NIN, GATE_OFF, C, MRG, D};
            pg8::gemm_phase<pg8::EpiMerge, pg8::SegOrder, true, true>(F.lds + RING_OFF, g, S, E, F.tid);
            if (!lastl) ctx_merge(F, (const bf16*)(wl + W_WMRG)); }
        SEAM(pb + 6);
        LAUNDER(); if (IN(pb + 7)) { pg8::Gemm g{MRG, (const bf16*)(wl + W_WOUT), D}; pg8::StaticOrder S; S.init(L, D, D, F.G, bx); pg8::EpiResid E{Hs, D, mlat + 5 * D, 1.0f};
            pg8::gemm_phase<pg8::EpiResid, pg8::StaticOrder, true, true>(F.lds + RING_OFF, g, S, E, F.tid);
            if (!lastl) ctx_resid(F, MRG, D, (const bf16*)(wl + W_WOUT), D, mctx + 5 * D, 1.0f); }
        SEAM(pb + 7);
        LAUNDER(); if (IN(pb + 8)) norm_phase<false>(F, l, ng + 2 * D, 6, 7);
        SEAM(pb + 8);
        LAUNDER(); if (IN(pb + 9)) { pg8::Gemm g{XN, (const bf16*)(wl + W_WI2), D}; pg8::StaticOrder S; S.init(MALL, 2 * FF, D, F.G, bx); pg8::EpiSwiglu E{ACT, FF};
            pg8::gemm_phase<pg8::EpiSwiglu, pg8::StaticOrder, true, true>(F.lds + RING_OFF, g, S, E, F.tid);
            convert_jobs(F, args, 8 * l + 7, (8 * l + 9 < 16) ? 8 * l + 9 : 16, F.ctl + CW_Q + (3 + 3 * l) * 64); }
        SEAM(pb + 9);
        LAUNDER(); if (IN(pb + 10)) { pg8::Gemm g{ACT, (const bf16*)(wl + W_WO2), FF}; pg8::StaticOrder S; S.init(L, D, FF, F.G, bx); pg8::EpiResid E{Hs, D, mlat + 8 * D, 0.5f};
            pg8::gemm_phase<pg8::EpiResid, pg8::StaticOrder, true, true>(F.lds + RING_OFF, g, S, E, F.tid);
            if (!lastl) ctx_resid(F, ACT, FF, (const bf16*)(wl + W_WO2), FF, mctx + 8 * D, 0.5f); }
        SEAM(pb + 10);
    }
    LAUNDER(); if (IN(NPHASE - 1)) norm_phase<true>(F, NLAYER - 1, args.in[20], 0, 0);
#undef IN
#undef SEAM
#undef LAUNDER
}

extern "C" void kernel_launch(void* const* d_in, const int* in_sizes, int n_in, void* d_out, int out_size, void* d_ws, size_t ws_size, hipStream_t stream) {
    static int grid = 0;
    if (grid == 0) {
        if (n_in != 21 || in_sizes[0] != L * D || out_size != L * D || ws_size < WS_END) { fprintf(stderr, "kernel_launch: shape mismatch n_in %d in0 %d out %d ws %zu (need %zu)\n", n_in, n_in > 0 ? in_sizes[0] : -1, out_size, ws_size, (size_t)WS_END); grid = -1; return; }
        int dev = 0, cus = 0, per_cu = 0;
        if (hipGetDevice(&dev) != hipSuccess || hipDeviceGetAttribute(&cus, hipDeviceAttributeMultiprocessorCount, dev) != hipSuccess) { grid = -1; return; }
        if (hipFuncSetAttribute((const void*)fwd, hipFuncAttributeMaxDynamicSharedMemorySize, LDS_BYTES) != hipSuccess) { fprintf(stderr, "kernel_launch: hipFuncSetAttribute failed\n"); grid = -1; return; }
        if (hipOccupancyMaxActiveBlocksPerMultiprocessor(&per_cu, (const void*)fwd, NWAVES * 64, LDS_BYTES) != hipSuccess || per_cu < 1) fprintf(stderr, "kernel_launch: occupancy query says %d\n", per_cu);
        (void)hipGetLastError();
        grid = cus;
    }
    if (grid < 0) return;
    (void)hipMemsetAsync((char*)d_ws + WS_CTL, 0, CTL_ZERO_BYTES, stream);
    Args a{};
    for (int i = 0; i < 21; ++i) a.in[i] = (const float*)d_in[i];
    a.out = (float*)d_out; a.ws = (unsigned char*)d_ws;
#if defined(MK_PER_PHASE)
    for (int ph = 0; ph < NPHASE; ++ph) { a.ph_lo = ph; a.ph_hi = ph + 1; hipLaunchKernelGGL(fwd, dim3(grid), dim3(NWAVES * 64), LDS_BYTES, stream, a); }
#else
    a.ph_lo = 0; a.ph_hi = NPHASE; hipLaunchKernelGGL(fwd, dim3(grid), dim3(NWAVES * 64), LDS_BYTES, stream, a);
#endif
    const hipError_t le = hipPeekAtLastError();
    if (le != hipSuccess) fprintf(stderr, "kernel_launch: launch failed: %s\n", hipGetErrorName(le));
}
```
